# Optimizing an MI355X kernel written in HIP

```python
import math
import jax, jax.numpy as jnp
from jax import lax
import numpy as np

D_MODEL = 1024
BATCH = 2
SEQ = 16384
DEPTH = 1
DEC_BATCH = 32
DEC_SEQ = 64
PAST_LEN = 2048

CHUNK = 64
N_PREV_CHUNKS = 8
BAND_PAST = N_PREV_CHUNKS * CHUNK
BAND_LEN = BAND_PAST + CHUNK
N_HEADS = 8
HEAD_DIM = 64
ATTN_DIM = N_HEADS * HEAD_DIM
CONV_DIM = D_MODEL // 2
CONV_K = 31
MAX_REL = 128
FFN_DIM = ((8 * D_MODEL + 3 * 256 - 1) // (3 * 256)) * 256
N_IN = 2 * CONV_DIM + 3 * ATTN_DIM + 2 * D_MODEL
ATTN_SCALE = 1.0 / math.sqrt(HEAD_DIM)
NORM_EPS = 1e-6
NEG_INF = -1e30

kernel_name = "streaming_conformer_conv_band_attn_hybrid"


def rms_norm(x, g):
    xf = x.astype(jnp.float32)
    y = xf * lax.rsqrt(jnp.mean(xf * xf, axis=-1, keepdims=True) + NORM_EPS)
    return (y * g.astype(jnp.float32)).astype(x.dtype)


def layer_norm(x, g, b):
    xf = x.astype(jnp.float32)
    mu = jnp.mean(xf, axis=-1, keepdims=True)
    var = jnp.mean(jnp.square(xf - mu), axis=-1, keepdims=True)
    y = (xf - mu) * lax.rsqrt(var + NORM_EPS)
    return (y * g.astype(jnp.float32) + b.astype(jnp.float32)).astype(x.dtype)


def conv_module(u, hist, w_dw, b_dw, ln_g, ln_b, w_out):
    ext = jnp.concatenate([hist, u], axis=1)
    y = lax.conv_general_dilated(
        ext, w_dw[:, None, :], window_strides=(1,), padding='VALID',
        dimension_numbers=('NWC', 'WIO', 'NWC'), feature_group_count=CONV_DIM)
    y = jax.nn.silu(layer_norm(y + b_dw, ln_g, ln_b))
    return y @ w_out, ext[:, -(CONV_K - 1):]


def band_attend(q, k, v, q_pos, k_pos, rel_bias):
    s = jnp.einsum('bqhd,bkhd->bhqk', q, k).astype(jnp.float32) * ATTN_SCALE
    rel = jnp.clip(q_pos[:, None] - k_pos[None, :], -MAX_REL, MAX_REL) + MAX_REL
    s = s + rel_bias[:, rel].astype(jnp.float32)[None]
    qc = (q_pos // CHUNK)[:, None]
    kc = (k_pos // CHUNK)[None, :]
    mask = (k_pos[None, :] >= 0) & (kc <= qc) & (kc >= qc - N_PREV_CHUNKS)
    s = jnp.where(mask[None, None], s, NEG_INF)
    p = jax.nn.softmax(s, axis=-1).astype(v.dtype)
    return jnp.einsum('bhqk,bkhd->bqhd', p, v)


def prompt_band_attention(q, k, v, rel_bias):
    B, T, H, Dh = q.shape
    nc = T // CHUNK
    pad = ((0, 0), (BAND_PAST, 0), (0, 0), (0, 0))
    kp = jnp.pad(k, pad)
    vp = jnp.pad(v, pad)
    qc = q.reshape(B, nc, CHUNK, H, Dh).swapaxes(0, 1)

    def one_chunk(args):
        qn, n = args
        start = n * CHUNK
        kb = lax.dynamic_slice_in_dim(kp, start, BAND_LEN, axis=1)
        vb = lax.dynamic_slice_in_dim(vp, start, BAND_LEN, axis=1)
        q_pos = start + jnp.arange(CHUNK, dtype=jnp.int32)
        k_pos = start - BAND_PAST + jnp.arange(BAND_LEN, dtype=jnp.int32)
        return band_attend(qn, kb, vb, q_pos, k_pos, rel_bias)

    o = lax.map(one_chunk, (qc, jnp.arange(nc, dtype=jnp.int32)))
    return o.swapaxes(0, 1).reshape(B, T, H, Dh)


def encoder_layer(x, c, conv_hist, attend, p):
    B, T, _ = x.shape
    mod = jax.nn.silu(c) @ p['w_ada'] + p['b_ada']
    sh1, sc1, gt1, sh2, sc2, gt2 = [m[:, None, :] for m in jnp.split(mod, 6, axis=-1)]

    h = rms_norm(x, p['norm1_g']) * (1 + sc1) + sh1
    z = h @ p['w_in']
    offs = np.cumsum([CONV_DIM, CONV_DIM, ATTN_DIM, ATTN_DIM, ATTN_DIM, D_MODEL])
    glu_a, glu_b, q, k, v, g_conv, g_attn = jnp.split(z, offs, axis=-1)

    u = glu_a * jax.nn.sigmoid(glu_b)
    conv_out, conv_state = conv_module(u, conv_hist, p['w_dw'], p['b_dw'],
                                       p['conv_ln_g'], p['conv_ln_b'], p['w_conv_out'])

    q = rms_norm(q.reshape(B, T, N_HEADS, HEAD_DIM), p['q_norm_g'])
    k = rms_norm(k.reshape(B, T, N_HEADS, HEAD_DIM), p['k_norm_g'])
    v = v.reshape(B, T, N_HEADS, HEAD_DIM)
    o = attend(q, k, v, p['rel_bias']).reshape(B, T, ATTN_DIM)
    attn_out = o @ p['w_attn_out']

    merged = jax.nn.sigmoid(g_conv) * conv_out + jax.nn.sigmoid(g_attn) * attn_out
    x = x + gt1 * (merged @ p['w_o'])

    h2 = rms_norm(x, p['norm2_g']) * (1 + sc2) + sh2
    gate, up = jnp.split(h2 @ p['w_ffn_in'], 2, axis=-1)
    x = x + gt2 * ((jax.nn.silu(gate) * up) @ p['w_ffn_out'])
    return x, conv_state, k, v


def setup_inputs(seed: int = 0) -> dict:
    key = jax.random.key(seed)
    ks = iter(jax.random.split(key, 32))
    f32 = jnp.float32
    cache_len = min(BAND_PAST, PAST_LEN)

    def nrm(shape, scale):
        return jax.random.normal(next(ks), shape, f32) * scale

    return {
        "x_prompt": nrm((BATCH, SEQ, D_MODEL), 1.0),
        "x_sample": nrm((DEC_BATCH, DEC_SEQ, D_MODEL), 1.0),
        "c_prompt": nrm((BATCH, D_MODEL), 1.0),
        "c_sample": nrm((DEC_BATCH, D_MODEL), 1.0),
        "cache_conv": nrm((DEPTH, DEC_BATCH, CONV_K - 1, CONV_DIM), 1.0),
        "cache_k": nrm((DEPTH, DEC_BATCH, cache_len, N_HEADS, HEAD_DIM), 1.0),
        "cache_v": nrm((DEPTH, DEC_BATCH, cache_len, N_HEADS, HEAD_DIM), 1.0),
        "norm1_g": 1.0 + nrm((DEPTH, D_MODEL), 0.02),
        "norm2_g": 1.0 + nrm((DEPTH, D_MODEL), 0.02),
        "w_ada": nrm((DEPTH, D_MODEL, 6 * D_MODEL), 0.5 * D_MODEL ** -0.5),
        "b_ada": nrm((DEPTH, 6 * D_MODEL), 0.02),
        "w_in": nrm((DEPTH, D_MODEL, N_IN), D_MODEL ** -0.5),
        "w_dw": nrm((DEPTH, CONV_K, CONV_DIM), CONV_K ** -0.5),
        "b_dw": nrm((DEPTH, CONV_DIM), 0.02),
        "conv_ln_g": 1.0 + nrm((DEPTH, CONV_DIM), 0.02),
        "conv_ln_b": nrm((DEPTH, CONV_DIM), 0.02),
        "w_conv_out": nrm((DEPTH, CONV_DIM, D_MODEL), CONV_DIM ** -0.5),
        "q_norm_g": 1.0 + nrm((DEPTH, HEAD_DIM), 0.02),
        "k_norm_g": 1.0 + nrm((DEPTH, HEAD_DIM), 0.02),
        "rel_bias": nrm((DEPTH, N_HEADS, 2 * MAX_REL + 1), 0.5),
        "w_attn_out": nrm((DEPTH, ATTN_DIM, D_MODEL), ATTN_DIM ** -0.5),
        "w_o": nrm((DEPTH, D_MODEL, D_MODEL), D_MODEL ** -0.5),
        "w_ffn_in": nrm((DEPTH, D_MODEL, 2 * FFN_DIM), D_MODEL ** -0.5),
        "w_ffn_out": nrm((DEPTH, FFN_DIM, D_MODEL), FFN_DIM ** -0.5),
    }


def reference(x_prompt, x_sample, c_prompt, c_sample, cache_conv, cache_k, cache_v,
              norm1_g, norm2_g, w_ada, b_ada, w_in, w_dw, b_dw, conv_ln_g, conv_ln_b,
              w_conv_out, q_norm_g, k_norm_g, rel_bias, w_attn_out, w_o, w_ffn_in, w_ffn_out):
    t_new = x_sample.shape[1]
    prompt_state_len = min(BAND_PAST, x_prompt.shape[1])
    xp, xs = x_prompt, x_sample
    conv_p_l, kp_l, vp_l, conv_s_l, ks_l, vs_l = [], [], [], [], [], []

    for l in range(DEPTH):
        p = {
            'norm1_g': norm1_g[l], 'norm2_g': norm2_g[l], 'w_ada': w_ada[l], 'b_ada': b_ada[l],
            'w_in': w_in[l], 'w_dw': w_dw[l], 'b_dw': b_dw[l], 'conv_ln_g': conv_ln_g[l],
            'conv_ln_b': conv_ln_b[l], 'w_conv_out': w_conv_out[l], 'q_norm_g': q_norm_g[l],
            'k_norm_g': k_norm_g[l], 'rel_bias': rel_bias[l], 'w_attn_out': w_attn_out[l],
            'w_o': w_o[l], 'w_ffn_in': w_ffn_in[l], 'w_ffn_out': w_ffn_out[l],
        }

        hist0 = jnp.zeros((xp.shape[0], CONV_K - 1, CONV_DIM), xp.dtype)
        xp, conv_p, k_p, v_p = encoder_layer(xp, c_prompt, hist0, prompt_band_attention, p)
        conv_p_l.append(conv_p)
        kp_l.append(k_p[:, -prompt_state_len:])
        vp_l.append(v_p[:, -prompt_state_len:])

        ck, cv = cache_k[l], cache_v[l]
        cache_len = ck.shape[1]

        def sample_attend(q, k, v, rb, ck=ck, cv=cv, cache_len=cache_len):
            k_all = jnp.concatenate([ck, k], axis=1)
            v_all = jnp.concatenate([cv, v], axis=1)
            q_pos = PAST_LEN + jnp.arange(t_new, dtype=jnp.int32)
            k_pos = jnp.concatenate(
                [PAST_LEN - cache_len + jnp.arange(cache_len, dtype=jnp.int32), q_pos])
            return band_attend(q, k_all, v_all, q_pos, k_pos, rb)

        xs, conv_s, k_s, v_s = encoder_layer(xs, c_sample, cache_conv[l], sample_attend, p)
        conv_s_l.append(conv_s)
        ks_l.append(k_s)
        vs_l.append(v_s)

    conv_state_prompt = jnp.stack(conv_p_l)
    k_state_prompt = jnp.stack(kp_l)
    v_state_prompt = jnp.stack(vp_l)
    conv_state_sample = jnp.stack(conv_s_l)
    k_new_sample = jnp.stack(ks_l)
    v_new_sample = jnp.stack(vs_l)
    return (xp, xs, conv_state_prompt, k_state_prompt, v_state_prompt,
            conv_state_sample, k_new_sample, v_new_sample)
```

```cpp
#include <hip/hip_runtime.h>
#include <hip/hip_cooperative_groups.h>
#include <cstdio>
#include <cstdint>
namespace cg = cooperative_groups;
namespace pg8 {
#define PG8_LAS __attribute__((address_space(3)))
typedef unsigned short bf16_t;
typedef short bf16x8 __attribute__((ext_vector_type(8)));
typedef float f32x4 __attribute__((ext_vector_type(4)));
typedef unsigned u32x4 __attribute__((ext_vector_type(4)));
constexpr int BM = 256, BK = 64, HALF = 128, HTB = HALF * BK * 2  , STAGE_BYTES = 8 * HTB, NXCD = 8, WGM = 8;

__host__ __device__ __forceinline__ int lds_byte(int r, int c) { const int st = (r >> 4) * 2 + (c >> 5), rr = r & 15, cc = c & 31, ob = rr * 64 + cc * 2; return st * 1024 + (ob ^ (((ob >> 9) & 1) << 5)); }
__host__ __device__ __forceinline__ void stage_rc(int b, int& R, int& C) { const int st = b / 1024, sb = b % 1024, swz = sb ^ (((sb >> 9) & 1) << 5); R = (st >> 1) * 16 + swz / 64; C = (st & 1) * 32 + (swz % 64) / 2; }
__host__ __device__ __forceinline__ int perm32(int rho) { const int n = rho >> 4, i = rho & 15; return 8 * (i >> 2) + 4 * n + (i & 3); }

struct Unit { int pm, pn, sub; };
struct Gemm { const bf16_t* A; const bf16_t* Bt; int M, N, K; };

struct StaticOrder {
    int nM, nN, nwg, G, c;
    __host__ __device__ void init(int M, int N, int G_, int c_) { nM = M / BM; nN = N / BM; nwg = nM * nN; G = G_; c = c_; }
    __host__ __device__ void map(int L, Unit& u) const {
        int wgid = L; { const int q = nwg / NXCD, r = nwg % NXCD, xcd = wgid % NXCD, off = wgid / NXCD; wgid = (xcd < r ? xcd * (q + 1) : r * (q + 1) + (xcd - r) * q) + off; }
        const int nig = WGM * nN, gid = wgid / nig, fm = gid * WGM, gsz = (nM - fm) < WGM ? (nM - fm) : WGM;
        u.pm = fm + ((wgid % nig) % gsz); u.pn = (wgid % nig) / gsz; u.sub = -1;
    }
    __host__ __device__ bool next(int i, Unit& u) const { const long L = (long)i * G + c; if (L >= nwg) return false; map((int)L, u); return true; }
    __device__ __forceinline__ void a_ready(const Unit&) const {}
    __device__ __forceinline__ void done(const Unit&) const {}
};

struct TailOrder {
    StaticOrder so; int nfull;
    __host__ __device__ void init(int M, int N, int G_, int c_) { so.init(M, N, G_, c_); nfull = (so.nwg / G_) * G_; }
    __host__ __device__ bool next(int i, Unit& u) const {
        const long L = (long)i * so.G + so.c;
        if (L < nfull) { so.map((int)L, u); return true; }
        const long Lq = L - nfull; if (Lq >= 4L * (so.nwg - nfull)) return false;
        so.map(nfull + (int)(Lq >> 2), u); u.sub = (int)(Lq & 3); return true;
    }
    __device__ __forceinline__ void a_ready(const Unit&) const {}
    __device__ __forceinline__ void done(const Unit&) const {}
};

__device__ __forceinline__ unsigned cvt_pk_bf16(float lo, float hi) { unsigned r; asm volatile("v_cvt_pk_bf16_f32 %0, %1, %2" : "=v"(r) : "v"(lo), "v"(hi)); return r; }
typedef float f32x2 __attribute__((ext_vector_type(2)));
template <class Epi, class Sched, bool ALIGN_EPI = false, bool SP2 = false>
__device__ __forceinline__ void gemm_phase(PG8_LAS unsigned char* lds, const Gemm g, const Sched& S, const Epi& E) {
    const int tid = threadIdx.x, wid = __builtin_amdgcn_readfirstlane(tid >> 6), lane = tid & 63, wr = wid >> 2, wc = wid & 3, fr = lane & 15, fq = lane >> 4;
    const int K = g.K, nt = K / BK;
    unsigned voffA[2], voffB[2];
#pragma unroll
    for (int i = 0; i < 2; ++i) { int R, C; stage_rc(tid * 16 + i * 8192, R, C); const int Rb = Epi::PERM ? ((R & ~31) + perm32(R & 31)) : R;
        voffA[i] = (unsigned)(R * K + C) * 2u; voffB[i] = (unsigned)(Rb * K + C) * 2u; }
    const size_t kstep = (size_t)(BK * 2);
    const size_t hstep = (size_t)HALF * K * 2;
    const size_t tstep = 2 * hstep;
    const unsigned ldsw = (unsigned)wid * 1024u;
    const int aoff = lds_byte(wr * 64 + fr, fq * 8), boff = lds_byte(wc * 32 + fr, fq * 8);
#define PG8_SA(b, h) (((b) * 2 + (h)) * HTB)
#define PG8_SB(b, h) ((4 + (b) * 2 + (h)) * HTB)
#define PG8_STAGE(bufoff, gbase, voff) do { _Pragma("unroll") for (int _i = 0; _i < 2; ++_i) \
        __builtin_amdgcn_global_load_lds((const unsigned*)((const char*)(gbase) + (voff)[_i]), (PG8_LAS unsigned*)(lds + (bufoff) + ldsw + _i * 8192), 16, 0, 0); } while (0)
#define PG8_LDA(dst, b, h) do { _Pragma("unroll") for (int m = 0; m < 4; ++m) _Pragma("unroll") for (int k = 0; k < 2; ++k) dst[m][k] = *(const PG8_LAS bf16x8*)(lds + PG8_SA(b, h) + aoff + m * 2048 + k * 1024); } while (0)
#define PG8_LDB(dst, b, h) do { _Pragma("unroll") for (int n = 0; n < 2; ++n) _Pragma("unroll") for (int k = 0; k < 2; ++k) dst[n][k] = *(const PG8_LAS bf16x8*)(lds + PG8_SB(b, h) + boff + n * 2048 + k * 1024); } while (0)
#define PG8_MMA(ai, bj, At, Bt) do { __builtin_amdgcn_s_setprio(1); _Pragma("unroll") for (int m = 0; m < 4; ++m) _Pragma("unroll") for (int n = 0; n < 2; ++n) _Pragma("unroll") for (int k = 0; k < 2; ++k) \
        acc[ai][bj][m][n] = __builtin_amdgcn_mfma_f32_16x16x32_bf16(Bt[n][k], At[m][k], acc[ai][bj][m][n], 0, 0, 0); __builtin_amdgcn_s_setprio(0); } while (0)
#define PG8_WAIT_V(n) asm volatile("s_waitcnt vmcnt(" #n ")" ::: "memory")
#define PG8_WAIT_L(n) asm volatile("s_waitcnt lgkmcnt(" #n ")" ::: "memory")
#define PG8_BAR __builtin_amdgcn_s_barrier()
#define PG8_SCHED __builtin_amdgcn_sched_barrier(0)
    Unit cur, nxt; int ui = 0;
    if (!S.next(0, cur)) return;
    f32x4 acc[2][2][4][2];
#pragma unroll
    for (int a = 0; a < 2; ++a)
#pragma unroll
        for (int b = 0; b < 2; ++b)
#pragma unroll
            for (int m = 0; m < 4; ++m)
#pragma unroll
                for (int n = 0; n < 2; ++n) acc[a][b][m][n] = (f32x4){0.f, 0.f, 0.f, 0.f};
    bf16x8 At[4][2], B0[2][2], B1[2][2];
#define PG8_AOFF(u) ((u).sub >= 2 ? hstep : (size_t)0)
#define PG8_BOFF(u) (((u).sub >= 0 && ((u).sub & 1)) ? hstep : (size_t)0)
    const char* cA = (const char*)g.A + (size_t)cur.pm * tstep + PG8_AOFF(cur); const char* cB = (const char*)g.Bt + (size_t)cur.pn * tstep + PG8_BOFF(cur);
    S.a_ready(cur);
    if constexpr (SP2) {
        PG8_STAGE(PG8_SB(0, 0), cB, voffB); PG8_STAGE(PG8_SB(0, 1), cB + hstep, voffB); PG8_STAGE(PG8_SA(0, 0), cA, voffA); PG8_STAGE(PG8_SA(0, 1), cA + hstep, voffA);
        if (wr == 1) PG8_BAR;
        PG8_WAIT_V(2); PG8_BAR;
        PG8_STAGE(PG8_SB(1, 0), cB + kstep, voffB); PG8_STAGE(PG8_SA(1, 0), cA + kstep, voffA); PG8_STAGE(PG8_SB(1, 1), cB + hstep + kstep, voffB);
        PG8_WAIT_V(6); PG8_BAR;
    } else {
        PG8_STAGE(PG8_SB(0, 0), cB, voffB); PG8_STAGE(PG8_SA(0, 0), cA, voffA); PG8_STAGE(PG8_SB(0, 1), cB + hstep, voffB); PG8_STAGE(PG8_SA(0, 1), cA + hstep, voffA);
        if (wr == 1) PG8_BAR;
        PG8_WAIT_V(4); PG8_BAR;
        PG8_STAGE(PG8_SB(1, 0), cB + kstep, voffB); PG8_STAGE(PG8_SA(1, 0), cA + kstep, voffA); PG8_STAGE(PG8_SB(1, 1), cB + hstep + kstep, voffB);
        PG8_WAIT_V(6); PG8_BAR;
    }
    for (;;) {
        const bool has_next = S.next(ui + 1, nxt);
        const char* nA = has_next ? (const char*)g.A + (size_t)nxt.pm * tstep + PG8_AOFF(nxt) : cA; const char* nB = has_next ? (const char*)g.Bt + (size_t)nxt.pn * tstep + PG8_BOFF(nxt) : cB;
        const bool full = cur.sub < 0;
        for (int t = 0; t < nt; t += 2) {
            const bool last = (t == nt - 2);
            const char* a1 = cA + (size_t)(t + 1) * kstep;
            const char* a2 = last ? nA : cA + (size_t)(t + 2) * kstep; const char* b2 = last ? nB : cB + (size_t)(t + 2) * kstep;
            const char* a3 = a2 + kstep; const char* b3 = b2 + kstep;
            if (last && has_next) S.a_ready(nxt);
            if constexpr (SP2) {
            PG8_LDB(B0, 0, 0); PG8_LDB(B1, 0, 1); PG8_SCHED; PG8_LDA(At, 0, 0); PG8_STAGE(PG8_SA(1, 1), a1 + hstep, voffA);
            PG8_WAIT_V(8); PG8_WAIT_L(0); PG8_BAR; PG8_MMA(0, 0, At, B0); if (full) PG8_MMA(0, 1, At, B1); PG8_BAR; PG8_SCHED;
            PG8_LDA(At, 0, 1); PG8_STAGE(PG8_SB(0, 0), b2, voffB); PG8_STAGE(PG8_SB(0, 1), b2 + hstep, voffB); PG8_STAGE(PG8_SA(0, 0), a2, voffA);
            PG8_WAIT_V(8); PG8_WAIT_L(0); PG8_BAR; if (full) { PG8_MMA(1, 0, At, B0); PG8_MMA(1, 1, At, B1); } PG8_BAR; PG8_SCHED;
            PG8_LDB(B0, 1, 0); PG8_LDB(B1, 1, 1); PG8_SCHED; PG8_LDA(At, 1, 0); PG8_STAGE(PG8_SA(0, 1), a2 + hstep, voffA);
            PG8_WAIT_V(8); PG8_WAIT_L(0); PG8_BAR; PG8_MMA(0, 0, At, B0); if (full) PG8_MMA(0, 1, At, B1); PG8_BAR; PG8_SCHED;
            PG8_LDA(At, 1, 1); PG8_STAGE(PG8_SB(1, 0), b3, voffB); PG8_STAGE(PG8_SB(1, 1), b3 + hstep, voffB); PG8_STAGE(PG8_SA(1, 0), a3, voffA);
            PG8_WAIT_V(8); PG8_WAIT_L(0); PG8_BAR; if (full) { PG8_MMA(1, 0, At, B0); PG8_MMA(1, 1, At, B1); } PG8_BAR; PG8_SCHED;
            } else {
            PG8_LDB(B0, 0, 0); PG8_SCHED; PG8_LDA(At, 0, 0); PG8_STAGE(PG8_SA(1, 1), a1 + hstep, voffA);
            PG8_WAIT_L(8); PG8_BAR; PG8_WAIT_L(0); PG8_MMA(0, 0, At, B0); PG8_BAR; PG8_SCHED;
            PG8_LDB(B1, 0, 1); PG8_STAGE(PG8_SB(0, 0), b2, voffB);
            PG8_BAR; PG8_WAIT_L(0); PG8_MMA(0, 1, At, B1); PG8_BAR;
            PG8_LDA(At, 0, 1); PG8_STAGE(PG8_SA(0, 0), a2, voffA);
            PG8_BAR; PG8_WAIT_L(0); PG8_MMA(1, 0, At, B0); PG8_BAR; PG8_SCHED;
            PG8_STAGE(PG8_SB(0, 1), b2 + hstep, voffB);
            PG8_WAIT_V(6); PG8_BAR; PG8_MMA(1, 1, At, B1); PG8_BAR;
            PG8_LDB(B0, 1, 0); PG8_SCHED; PG8_LDA(At, 1, 0); PG8_STAGE(PG8_SA(0, 1), a2 + hstep, voffA);
            PG8_WAIT_L(8); PG8_BAR; PG8_WAIT_L(0); PG8_MMA(0, 0, At, B0); PG8_BAR; PG8_SCHED;
            PG8_LDB(B1, 1, 1); PG8_STAGE(PG8_SB(1, 0), b3, voffB);
            PG8_BAR; PG8_WAIT_L(0); PG8_MMA(0, 1, At, B1); PG8_BAR;
            PG8_LDA(At, 1, 1); PG8_STAGE(PG8_SA(1, 0), a3, voffA);
            PG8_BAR; PG8_WAIT_L(0); PG8_MMA(1, 0, At, B0); PG8_BAR; PG8_SCHED;
            PG8_STAGE(PG8_SB(1, 1), b3 + hstep, voffB);
            PG8_WAIT_V(6); PG8_BAR; PG8_MMA(1, 1, At, B1); PG8_BAR;
            }
        }
        if constexpr (ALIGN_EPI) { if (wr == 0) PG8_BAR; }
        if constexpr (!Epi::AFTER_DRAIN) { E(acc, cur, wr, wc, fr, fq); S.done(cur); }
        if (!has_next) break;
        if (!E.keep_acc(cur)) {
#pragma unroll
        for (int a = 0; a < 2; ++a)
#pragma unroll
            for (int b = 0; b < 2; ++b)
#pragma unroll
                for (int m = 0; m < 4; ++m)
#pragma unroll
                    for (int n = 0; n < 2; ++n) acc[a][b][m][n] = (f32x4){0.f, 0.f, 0.f, 0.f};
        }
        cur = nxt; cA = nA; cB = nB; ++ui;
        if constexpr (ALIGN_EPI) { if (wr == 1) PG8_BAR; }
    }
    PG8_WAIT_V(0);
    if constexpr (!ALIGN_EPI) { if (wr == 0) PG8_BAR; }
    PG8_BAR;
    if constexpr (Epi::AFTER_DRAIN) { E.fused(acc, cur, wr, wc, fr, fq, lds, wid, lane); S.done(cur); }
#undef PG8_AOFF
#undef PG8_BOFF
#undef PG8_SA
#undef PG8_SB
#undef PG8_STAGE
#undef PG8_LDA
#undef PG8_LDB
#undef PG8_MMA
#undef PG8_WAIT_V
#undef PG8_WAIT_L
#undef PG8_BAR
#undef PG8_SCHED
}
}

#define LAS __attribute__((address_space(3)))
typedef unsigned short bf16_t;
typedef float f32x4 __attribute__((ext_vector_type(4)));
typedef float f32x2 __attribute__((ext_vector_type(2)));
typedef float f32x16 __attribute__((ext_vector_type(16)));
typedef short bf16x8 __attribute__((ext_vector_type(8)));
typedef short s16x4 __attribute__((ext_vector_type(4)));
typedef unsigned u32x4 __attribute__((ext_vector_type(4)));
typedef unsigned u32x2 __attribute__((ext_vector_type(2)));

constexpr int DM = 1024, TP = 16384, NBP = 2, NBS = 32, TS = 64;
constexpr int NTP = NBP * TP, NTS = NBS * TS, NTOK = NTP + NTS;
constexpr int NB = NBP + NBS;
constexpr int AD = 512, CD = 512, NHEAD = 8, HD = 64, FF = 2816, NIN = 4608, CK = 31, BANDP = 512, SKV = 576;
constexpr int NROWT = NTOK / 256;
constexpr float EPS = 1e-6f, LOG2E = 1.4426950408889634f, QSCALE = 0.125f * 1.4426950408889634f;
constexpr int NWAVES = 8, NTHREADS = 512;

constexpr size_t MiB = 1u << 20;
constexpr size_t WS_BAR = 1 * MiB + 896 * 1024  , WS_MOD = 0, WS_CVEC = 1 * MiB, WS_WC = 2 * MiB, WS_WA = 3 * MiB, WS_WO = 4 * MiB, WS_WF1 = 6 * MiB, WS_WF2 = 17 * MiB;
constexpr size_t WS_WIN = 24 * MiB, WS_H = 32 * MiB, WS_WV = 100 * MiB, WS_U = 101 * MiB, WS_Q = 135 * MiB, WS_K = 169 * MiB, WS_VT = 219 * MiB, WS_SG = 269 * MiB, WS_SS = 405 * MiB;
constexpr size_t WS_Y = 32 * MiB, WS_O = 66 * MiB, WS_M1 = 101 * MiB, WS_MG = 169 * MiB, WS_A2 = 269 * MiB, WS_X1 = 337 * MiB, WS_ACT = 32 * MiB, WS_END = 410 * MiB;
static_assert(WS_H - WS_WIN == (size_t)4096 * 1024 * 2 && WS_WV - WS_H == (size_t)NTOK * 1024 * 2, "concatenated [Win | H | Wv] tile space");
constexpr size_t OUT_Y = 0, OUT_CSP = 35651584, OUT_KSP = 35682304, OUT_VSP = 36206592, OUT_CSS = 36730880, OUT_KNS = 37222400, OUT_VNS = 38270976, OUT_END = 39319552;
constexpr int LDS_BYTES = 147456;

__device__ __forceinline__ unsigned pk2(float lo, float hi) { typedef __bf16 b2 __attribute__((ext_vector_type(2))); f32x2 v = {lo, hi}; b2 b = __builtin_convertvector(v, b2); return __builtin_bit_cast(unsigned, b); }
__device__ __forceinline__ float bf_lo(unsigned w) { return __uint_as_float(w << 16); }
__device__ __forceinline__ float bf_hi(unsigned w) { return __uint_as_float(w & 0xffff0000u); }
__device__ __forceinline__ float sigm(float x) { return __builtin_amdgcn_rcpf(1.f + __builtin_amdgcn_exp2f(-LOG2E * x)); }
__device__ __forceinline__ u32x4 pack8(f32x4 a, f32x4 b) { u32x4 w; w.x = pk2(a[0], a[1]); w.y = pk2(a[2], a[3]); w.z = pk2(b[0], b[1]); w.w = pk2(b[2], b[3]); return w; }
__device__ __forceinline__ int bid_of(int row) { return row < NTP ? (row >> 14) : NBP + ((row - NTP) >> 6); }
__device__ __forceinline__ float wave_sum(float v) {
#pragma unroll
    for (int o = 1; o < 64; o <<= 1) v += __shfl_xor(v, o);
    return v;
}
__device__ __forceinline__ float quad_sum(float v) { v += __shfl_xor(v, 16); v += __shfl_xor(v, 32); return v; }

typedef const f32x4 (&AccRef)[2][2][4][2];

struct EpiIn {
    static constexpr bool PERM = true, AFTER_DRAIN = false;
    __device__ __forceinline__ bool keep_acc(const pg8::Unit&) const { return false; }
    bf16_t *U, *Q, *K, *VT, *SG; float* out; const float *qg, *kg;
    __device__ __forceinline__ void operator()(AccRef acc, const pg8::Unit& u, int wr, int wc, int fr, int fq) const {
        if (u.pm >= 16 + NROWT) {
            const int dg0 = (u.pm - 16 - NROWT) * 256 + wr * 64 + fr, tk0 = (u.pn - 16) * 256 + wc * 32 + fq * 8;
#pragma unroll
            for (int ai = 0; ai < 2; ++ai)
#pragma unroll
                for (int m = 0; m < 4; ++m) { const int dg = dg0 + ai * 128 + m * 16;
#pragma unroll
                    for (int bj = 0; bj < 2; ++bj) { const int tok = tk0 + bj * 128; const f32x4 v0 = acc[ai][bj][m][0], v1 = acc[ai][bj][m][1]; const u32x4 w = pack8(v0, v1);
                        int kidx; float* o;
                        if (tok < NTP) { const int b = tok >> 14, t = tok & (TP - 1); kidx = tok; o = (t >= TP - BANDP) ? out + OUT_VSP + ((size_t)(b * BANDP + t - (TP - BANDP)) * AD + dg) : nullptr; }
                        else { const int ts = tok - NTP; kidx = NTP + (ts >> 6) * SKV + BANDP + (ts & 63); o = out + OUT_VNS + ((size_t)ts * AD + dg); }
                        { const int kv0 = kidx & 63; bf16_t* vp = VT + ((size_t)((kidx >> 6) * NHEAD + (dg >> 6)) * 8 + ((dg >> 5) & 1) * 4 + (kv0 >> 4)) * 512 + (dg & 31) * 8 + ((kv0 >> 3) & 1) * 4;
                          *(u32x2*)vp = (u32x2){w.x, w.y}; *(u32x2*)(vp + 256) = (u32x2){w.z, w.w}; }
                        if (o) {
#pragma unroll
                            for (int j = 0; j < 4; ++j) { o[(size_t)j * AD] = v0[j]; o[(size_t)(j + 4) * AD] = v1[j]; } }
                    } }
            return;
        }
        const int row0 = (u.pm - 16) * 256 + wr * 64 + fr, pn = u.pn, cw = wc * 32 + fq * 8;
        if (pn < 4) {
#pragma unroll
            for (int ai = 0; ai < 2; ++ai)
#pragma unroll
                for (int m = 0; m < 4; ++m) { const int row = row0 + ai * 128 + m * 16; f32x4 r0, r1;
#pragma unroll
                    for (int e = 0; e < 4; ++e) { r0[e] = acc[ai][0][m][0][e] * sigm(acc[ai][1][m][0][e]); r1[e] = acc[ai][0][m][1][e] * sigm(acc[ai][1][m][1][e]); }
                    *(u32x4*)(U + (size_t)row * CD + pn * 128 + cw) = pack8(r0, r1); }
        } else if (pn < 8) {
            const bool isk = pn >= 6; const int head = ((pn - 4) & 1) * 4 + wc; const float* g = isk ? kg : qg; const float sc = isk ? 1.f : QSCALE;
            f32x4 gv[2][2];
#pragma unroll
            for (int bj = 0; bj < 2; ++bj)
#pragma unroll
                for (int n = 0; n < 2; ++n) gv[bj][n] = *(const f32x4*)(g + bj * 32 + fq * 8 + n * 4) * sc;
#pragma unroll
            for (int ai = 0; ai < 2; ++ai)
#pragma unroll
                for (int m = 0; m < 4; ++m) { const int row = row0 + ai * 128 + m * 16; float ss = 0.f;
#pragma unroll
                    for (int bj = 0; bj < 2; ++bj)
#pragma unroll
                        for (int n = 0; n < 2; ++n) { const f32x4 v = acc[ai][bj][m][n]; ss += (v[0] * v[0] + v[1] * v[1]) + (v[2] * v[2] + v[3] * v[3]); }
                    ss = quad_sum(ss); const float rstd = rsqrtf(ss * (1.f / 64.f) + EPS);
                    f32x4 o[2][2];
#pragma unroll
                    for (int bj = 0; bj < 2; ++bj)
#pragma unroll
                        for (int n = 0; n < 2; ++n) o[bj][n] = acc[ai][bj][m][n] * rstd * gv[bj][n];
                    const int hc = head * HD + fq * 8;
                    if (!isk) {
#pragma unroll
                        for (int bj = 0; bj < 2; ++bj) *(u32x4*)(Q + (size_t)row * AD + hc + bj * 32) = pack8(o[bj][0], o[bj][1]);
                    } else {
                        size_t krow; float* fo;
                        if (row < NTP) { krow = (size_t)row; const int b = row >> 14, t = row & (TP - 1); fo = (t >= TP - BANDP) ? out + OUT_KSP + (size_t)(b * BANDP + t - (TP - BANDP)) * AD : nullptr; }
                        else { const int ts = row - NTP; krow = (size_t)NTP + (size_t)(ts >> 6) * SKV + BANDP + (ts & 63); fo = out + OUT_KNS + (size_t)ts * AD; }
#pragma unroll
                        for (int bj = 0; bj < 2; ++bj) { *(u32x4*)(K + ((size_t)((krow >> 6) * NHEAD + head) * 8 + (((int)krow >> 5) & 1) * 4 + 2 * bj + (fq >> 1)) * 512 + ((fq & 1) * 32 + ((int)krow & 31)) * 8) = pack8(o[bj][0], o[bj][1]);
                            if (fo) { *(f32x4*)(fo + hc + bj * 32) = o[bj][0]; *(f32x4*)(fo + hc + bj * 32 + 4) = o[bj][1]; } }
                    } }
        } else {
#pragma unroll
            for (int ai = 0; ai < 2; ++ai)
#pragma unroll
                for (int m = 0; m < 4; ++m) { const int row = row0 + ai * 128 + m * 16; f32x4 r[2], t2[2];
#pragma unroll
                    for (int n = 0; n < 2; ++n)
#pragma unroll
                        for (int e = 0; e < 4; ++e) { const float ec = __builtin_amdgcn_exp2f(-LOG2E * acc[ai][0][m][n][e]), ea = fminf(__builtin_amdgcn_exp2f(-LOG2E * acc[ai][1][m][n][e]), 1e30f);
                            r[n][e] = (1.f + ea) * __builtin_amdgcn_rcpf(1.f + ec); t2[n][e] = __builtin_amdgcn_rcpf(1.f + ea); }
                    *(u32x4*)(SG + (size_t)row * 2048 + (pn - 8) * 128 + cw) = pack8(r[0], r[1]);
                    *(u32x4*)(SG + (size_t)row * 2048 + 1024 + (pn - 8) * 128 + cw) = pack8(t2[0], t2[1]); }
        }
    }
};
struct OrderIn {
    pg8::StaticOrder so; int G, c;
    __device__ __forceinline__ void init(int G_, int c_) { so.init(NTOK, 4096, G_, c_); G = G_; c = c_; }
    __device__ __forceinline__ bool next(int i, pg8::Unit& u) const {
        if (so.next(i, u)) { u.pm += 16; return true; }
        const int Lv = i * G + c - NROWT * 16; if (Lv >= 2 * NROWT) return false;
        u.pm = 16 + NROWT + (Lv & 1); u.pn = 16 + (Lv >> 1); u.sub = -1; return true;
    }
    __device__ __forceinline__ void a_ready(const pg8::Unit&) const {}
    __device__ __forceinline__ void done(const pg8::Unit&) const {}
};
template <int SECOND> struct EpiMerge {
    static constexpr bool PERM = true, AFTER_DRAIN = false;
    __device__ __forceinline__ bool keep_acc(const pg8::Unit&) const { return false; }
    const bf16_t* SG; bf16_t* M1; bf16_t* MG;
    __device__ __forceinline__ void operator()(AccRef acc, const pg8::Unit& u, int wr, int wc, int fr, int fq) const {
        const bool qt = u.sub >= 0; const int roff = u.sub >= 2 ? 128 : 0, coff = (qt && (u.sub & 1)) ? 128 : 0;
        const int row0 = u.pm * 256 + roff + wr * 64 + fr, col0 = u.pn * 256 + coff + wc * 32 + fq * 8;
#pragma unroll
        for (int ai = 0; ai < 2; ++ai) { if (qt && ai) break;
#pragma unroll
            for (int m = 0; m < 4; ++m) { const int row = row0 + ai * 128 + m * 16;
#pragma unroll
                for (int bj = 0; bj < 2; ++bj) { if (qt && bj) break; const int col = col0 + bj * 128;
                    const u32x4 gw = *(const u32x4*)(SG + (size_t)row * 2048 + SECOND * 1024 + col);
                    f32x4 r0 = acc[ai][bj][m][0], r1 = acc[ai][bj][m][1];
                    r0[0] *= bf_lo(gw.x); r0[1] *= bf_hi(gw.x); r0[2] *= bf_lo(gw.y); r0[3] *= bf_hi(gw.y); r1[0] *= bf_lo(gw.z); r1[1] *= bf_hi(gw.z); r1[2] *= bf_lo(gw.w); r1[3] *= bf_hi(gw.w);
                    if (SECOND) { const u32x4 pw = *(const u32x4*)(M1 + (size_t)row * DM + col);
                        r0[0] += bf_lo(pw.x); r0[1] += bf_hi(pw.x); r0[2] += bf_lo(pw.y); r0[3] += bf_hi(pw.y); r1[0] += bf_lo(pw.z); r1[1] += bf_hi(pw.z); r1[2] += bf_lo(pw.w); r1[3] += bf_hi(pw.w);
                        *(u32x4*)(MG + (size_t)row * DM + col) = pack8(r0, r1);
                    } else *(u32x4*)(M1 + (size_t)row * DM + col) = pack8(r0, r1); } } }
    }
};
struct EpiMergeFused {
    static constexpr bool PERM = true, AFTER_DRAIN = false;
    const bf16_t* SG; bf16_t* MG;
    __device__ __forceinline__ bool keep_acc(const pg8::Unit& u) const { return u.pm < NROWT; }
    __device__ __forceinline__ void operator()(f32x4 (&acc)[2][2][4][2], const pg8::Unit& u, int wr, int wc, int fr, int fq) const {
        const bool second = u.pm >= NROWT; const int pm = second ? u.pm - NROWT : u.pm, pn = second ? u.pn - 4 : u.pn;
        const bool qt = u.sub >= 0; const int roff = u.sub >= 2 ? 128 : 0, coff = (qt && (u.sub & 1)) ? 128 : 0;
        const int row0 = pm * 256 + roff + wr * 64 + fr, col0 = pn * 256 + coff + wc * 32 + fq * 8;
#pragma unroll
        for (int ai = 0; ai < 2; ++ai) { if (qt && ai) break;
#pragma unroll
            for (int m = 0; m < 4; ++m) { const int row = row0 + ai * 128 + m * 16;
#pragma unroll
                for (int bj = 0; bj < 2; ++bj) { if (qt && bj) break; const int col = col0 + bj * 128;
                    const u32x4 gw = *(const u32x4*)(SG + (size_t)row * 2048 + (second ? 1024 : 0) + col);
                    const f32x4 ga = {bf_lo(gw.x), bf_hi(gw.x), bf_lo(gw.y), bf_hi(gw.y)}, gb = {bf_lo(gw.z), bf_hi(gw.z), bf_lo(gw.w), bf_hi(gw.w)};
                    if (!second) { acc[ai][bj][m][0] *= ga; acc[ai][bj][m][1] *= gb; }
                    else *(u32x4*)(MG + (size_t)row * DM + col) = pack8(acc[ai][bj][m][0] * ga, acc[ai][bj][m][1] * gb); } } }
    }
};
struct PairOrder {
    pg8::TailOrder t;
    __device__ __forceinline__ void init(int M, int N, int G_, int c_) { t.init(M, N, G_, c_); }
    __device__ __forceinline__ bool next(int i, pg8::Unit& u) const { if (!t.next(i >> 1, u)) return false; if (i & 1) { u.pm += NROWT; u.pn += 4; } return true; }
    __device__ __forceinline__ void a_ready(const pg8::Unit&) const {}
    __device__ __forceinline__ void done(const pg8::Unit&) const {}
};
struct EpiX1 {
    static constexpr bool PERM = true, AFTER_DRAIN = false;
    __device__ __forceinline__ bool keep_acc(const pg8::Unit&) const { return false; }
    const float *xp, *xs, *mod, *g2; bf16_t* X1; bf16_t* A2; float* SS;
    __device__ __forceinline__ void operator()(AccRef acc, const pg8::Unit& u, int wr, int wc, int fr, int fq) const {
        const bool qt = u.sub >= 0; const int roff = u.sub >= 2 ? 128 : 0, cq = (qt && (u.sub & 1)) ? 1 : 0;
        const int col0 = u.pn * 256 + cq * 128 + wc * 32 + fq * 8;
#pragma unroll
        for (int ai = 0; ai < 2; ++ai) { if (qt && ai) break; const int rowa = u.pm * 256 + roff + ai * 128 + wr * 64; const int b = bid_of(rowa); const float* mb = mod + (size_t)b * 6144;
            f32x4 gt[2][2], gs[2][2];
#pragma unroll
            for (int bj = 0; bj < 2; ++bj)
#pragma unroll
                for (int n = 0; n < 2; ++n) { const int col = col0 + bj * 128 + n * 4; if (qt && bj) { gt[bj][n] = gt[0][n]; gs[bj][n] = gs[0][n]; } else { gt[bj][n] = *(const f32x4*)(mb + 2048 + col); gs[bj][n] = *(const f32x4*)(g2 + col) * (*(const f32x4*)(mb + 4096 + col) + 1.f); } }
#pragma unroll
            for (int m = 0; m < 4; ++m) { const int row = rowa + m * 16 + fr; const float* xr = row < NTP ? xp + (size_t)row * DM : xs + (size_t)(row - NTP) * DM;
#pragma unroll
                for (int bj = 0; bj < 2; ++bj) { if (qt && bj) break; f32x4 x1[2]; float ss = 0.f;
#pragma unroll
                    for (int n = 0; n < 2; ++n) { const int col = col0 + bj * 128 + n * 4; x1[n] = *(const f32x4*)(xr + col) + gt[bj][n] * acc[ai][bj][m][n];
                        ss += (x1[n][0] * x1[n][0] + x1[n][1] * x1[n][1]) + (x1[n][2] * x1[n][2] + x1[n][3] * x1[n][3]); }
                    *(u32x4*)(X1 + (size_t)row * DM + col0 + bj * 128) = pack8(x1[0], x1[1]);
                    *(u32x4*)(A2 + (size_t)row * DM + col0 + bj * 128) = pack8(x1[0] * gs[bj][0], x1[1] * gs[bj][1]);
                    ss = quad_sum(ss); if (fq == 0) SS[(size_t)row * 32 + u.pn * 8 + (cq + bj) * 4 + wc] = ss; } } }
    }
};
struct EpiFfn {
    static constexpr bool PERM = true, AFTER_DRAIN = false;
    __device__ __forceinline__ bool keep_acc(const pg8::Unit&) const { return false; }
    const float *SS, *cvec; bf16_t* ACT;
    __device__ __forceinline__ void operator()(AccRef acc, const pg8::Unit& u, int wr, int wc, int fr, int fq) const {
        const int cl = u.pn * 128 + wc * 32 + fq * 8;
#pragma unroll
        for (int ai = 0; ai < 2; ++ai) { const int rowa = u.pm * 256 + ai * 128 + wr * 64; const int b = bid_of(rowa); const float* cb = cvec + (size_t)b * (2 * FF) + cl;
            const f32x4 cg0 = *(const f32x4*)(cb), cg1 = *(const f32x4*)(cb + 4), cu0 = *(const f32x4*)(cb + FF), cu1 = *(const f32x4*)(cb + FF + 4);
#pragma unroll
            for (int m = 0; m < 4; ++m) { const int row = rowa + m * 16 + fr; const f32x4 pt = *(const f32x4*)(SS + (size_t)row * 32 + fq * 8), pu = *(const f32x4*)(SS + (size_t)row * 32 + fq * 8 + 4);
                const float rstd = rsqrtf(quad_sum(((pt[0] + pt[1]) + (pt[2] + pt[3])) + ((pu[0] + pu[1]) + (pu[2] + pu[3]))) * (1.f / DM) + EPS);
                const f32x4 g0 = acc[ai][0][m][0] * rstd + cg0, g1 = acc[ai][0][m][1] * rstd + cg1, u0 = acc[ai][1][m][0] * rstd + cu0, u1 = acc[ai][1][m][1] * rstd + cu1; f32x4 r0, r1;
#pragma unroll
                for (int e = 0; e < 4; ++e) { r0[e] = g0[e] * sigm(g0[e]) * u0[e]; r1[e] = g1[e] * sigm(g1[e]) * u1[e]; }
                *(u32x4*)(ACT + (size_t)row * FF + cl) = pack8(r0, r1); } }
    }
};
struct EpiOut {
    static constexpr bool PERM = true, AFTER_DRAIN = false;
    __device__ __forceinline__ bool keep_acc(const pg8::Unit&) const { return false; }
    const float* mod; const bf16_t* X1; float* Y;
    __device__ __forceinline__ void operator()(AccRef acc, const pg8::Unit& u, int wr, int wc, int fr, int fq) const {
        const bool qt = u.sub >= 0; const int roff = u.sub >= 2 ? 128 : 0, coff = (qt && (u.sub & 1)) ? 128 : 0;
        const int col0 = u.pn * 256 + coff + wc * 32 + fq * 8;
#pragma unroll
        for (int ai = 0; ai < 2; ++ai) { if (qt && ai) break; const int rowa = u.pm * 256 + roff + ai * 128 + wr * 64; const int b = bid_of(rowa); const float* mb = mod + (size_t)b * 6144 + 5120;
#pragma unroll
            for (int m = 0; m < 4; ++m) { const size_t ro = (size_t)(rowa + m * 16 + fr) * DM;
#pragma unroll
                for (int bj = 0; bj < 2; ++bj) { if (qt && bj) break; const int col = col0 + bj * 128; const u32x4 xw = *(const u32x4*)(X1 + ro + col);
                    *(f32x4*)(Y + ro + col) = (f32x4){bf_lo(xw.x), bf_hi(xw.x), bf_lo(xw.y), bf_hi(xw.y)} + *(const f32x4*)(mb + col) * acc[ai][bj][m][0];
                    *(f32x4*)(Y + ro + col + 4) = (f32x4){bf_lo(xw.z), bf_hi(xw.z), bf_lo(xw.w), bf_hi(xw.w)} + *(const f32x4*)(mb + col + 4) * acc[ai][bj][m][1]; } } }
    }
};

__device__ __forceinline__ void tr_item(const float* W, int N, int k0, int n0, bf16_t* WT, size_t ldo, int drowA, int drowB, LAS float* scr, int lane) {
    f32x4 v[16];
    const float* wp = W + (size_t)(k0 + (lane >> 4)) * N + n0 + (lane & 15) * 4;
#pragma unroll
    for (int i = 0; i < 16; ++i) v[i] = *(const f32x4*)(wp + (size_t)(4 * i) * N);
#pragma unroll
    for (int i = 0; i < 16; ++i) { LAS float* d = scr + (4 * i + (lane >> 4)) * 65 + (lane & 15) * 4; d[0] = v[i][0]; d[1] = v[i][1]; d[2] = v[i][2]; d[3] = v[i][3]; }
    asm volatile("s_waitcnt lgkmcnt(0)" ::: "memory");
    const int c = lane & 7;
#pragma unroll
    for (int j = 0; j < 8; ++j) { const int n = (lane >> 3) + 8 * j; const LAS float* sp = scr + (8 * c) * 65 + n;
        u32x4 o; o.x = pk2(sp[0 * 65], sp[1 * 65]); o.y = pk2(sp[2 * 65], sp[3 * 65]); o.z = pk2(sp[4 * 65], sp[5 * 65]); o.w = pk2(sp[6 * 65], sp[7 * 65]);
        const int drow = (j < 4 ? drowA + n : drowB + n - 32);
        *(u32x4*)(WT + (size_t)drow * ldo + k0 + 8 * c) = o; }
    asm volatile("s_waitcnt lgkmcnt(0)" ::: "memory");
}
__device__ __forceinline__ int win_dest(int n0) {
    if (n0 < 512) return 256 * (n0 >> 7) + (n0 & 127);
    if (n0 < 1024) { const int n = n0 - 512; return 256 * (n >> 7) + 128 + (n & 127); }
    if (n0 < 2048) { const int base = n0 < 1536 ? 1024 : 1536, n = n0 - base; return base + 256 * (n >> 8) + 128 * ((n & 63) >> 5) + 32 * ((n & 255) >> 6); }
    if (n0 < 2560) return -(n0 - 2048) - 1;
    if (n0 < 3584) { const int n = n0 - 2560; return 2048 + 256 * (n >> 7) + (n & 127); }
    { const int n = n0 - 3584; return 2048 + 256 * (n >> 7) + 128 + (n & 127); }
}
__device__ __forceinline__ int ffn_dest(int n0) { if (n0 < FF) return 256 * (n0 >> 7) + (n0 & 127); const int n = n0 - FF; return 256 * (n >> 7) + 128 + (n & 127); }

template <int MODE> __device__ __forceinline__ void gemv34(LAS unsigned char* lds, int task, const float* W, int N, const float* bias, float* out, const float* cp, const float* cs, const float* mod, int tid, int lane, int wave) {
    LAS float* S = (LAS float*)lds;
    { f32x2 sv[NB];
#pragma unroll
      for (int b = 0; b < NB; ++b) sv[b] = MODE == 0 ? *(const f32x2*)((b < NBP ? cp + b * DM : cs + (b - NBP) * DM) + 2 * tid) : *(const f32x2*)(mod + (size_t)b * 6144 + 3072 + 2 * tid);
#pragma unroll
      for (int b = 0; b < NB; ++b) { f32x2 v = sv[b]; if (MODE == 0) { v[0] *= sigm(v[0]); v[1] *= sigm(v[1]); } *(LAS f32x2*)(S + b * DM + 2 * tid) = v; } }
    __syncthreads();
    float acc[NB];
#pragma unroll
    for (int b = 0; b < NB; ++b) acc[b] = 0.f;
    const int kbase = wave * 128 + (lane >> 5) * 64;
    const float* wp = W + (size_t)kbase * N + task * 32 + (lane & 31);
    const LAS float* sp = S + kbase;
#pragma unroll 2
    for (int k4 = 0; k4 < 16; ++k4) { const float w0 = wp[0], w1 = wp[N], w2 = wp[2 * (size_t)N], w3 = wp[3 * (size_t)N]; wp += 4 * (size_t)N;
#pragma unroll
        for (int b = 0; b < NB; ++b) { const f32x4 s4 = *(const LAS f32x4*)(sp + b * DM + 4 * k4); acc[b] += (s4[0] * w0 + s4[1] * w1) + (s4[2] * w2 + s4[3] * w3); } }
    __syncthreads();
#pragma unroll
    for (int b = 0; b < NB; ++b) S[(wave * NB + b) * 64 + lane] = acc[b];
    __syncthreads();
    for (int idx = tid; idx < NB * 32; idx += NTHREADS) { const int b = idx >> 5, c = idx & 31; float s = 0.f;
#pragma unroll
        for (int w = 0; w < NWAVES; ++w) s += S[(w * NB + b) * 64 + c] + S[(w * NB + b) * 64 + 32 + c];
        out[(size_t)b * N + task * 32 + c] = s + (bias ? bias[task * 32 + c] : 0.f); }
    __syncthreads();
}

__device__ __forceinline__ void conv_unit(int cu, LAS unsigned char* lds, const bf16_t* U, const float* cache_conv, const f32x2 (&w)[CK], const f32x2 bb, const float* ln_g, const float* ln_b, bf16_t* Y, float* out, int tid, int lane, int wave) {
    int tokbase, t0, T, seq; const bool samp = cu >= 1024;
    if (!samp) { seq = cu >> 9; t0 = (cu & 511) * 32; tokbase = seq * TP; T = TP; } else { const int c2 = cu - 1024; seq = c2 >> 1; t0 = (c2 & 1) * 32; tokbase = NTP + seq * TS; T = TS; }
    LAS unsigned* inb = (LAS unsigned*)lds;
    LAS float* yb = (LAS float*)(lds + 63488);
    for (int r = wave; r < 62; r += NWAVES) { const int t = t0 - 30 + r;
        if (t >= 0) __builtin_amdgcn_global_load_lds((const unsigned*)(U + (size_t)(tokbase + t) * CD + lane * 8), (LAS unsigned*)(inb + r * 256), 16, 0, 0);
        else { u32x4 v = {0u, 0u, 0u, 0u};
            if (samp) { const float* cc = cache_conv + ((size_t)seq * 30 + 30 + t) * CD + lane * 8; v = pack8(*(const f32x4*)cc, *(const f32x4*)(cc + 4)); }
            *(LAS u32x4*)(inb + r * 256 + lane * 4) = v; } }
    asm volatile("s_waitcnt vmcnt(0)" ::: "memory");
    __syncthreads();
    if (t0 == T - 32) {
        float* o = out + (samp ? OUT_CSS : OUT_CSP) + (size_t)seq * 30 * CD;
        for (int idx = tid; idx < 30 * 256; idx += NTHREADS) { const int r = idx >> 8, c2 = idx & 255; const unsigned v = inb[(32 + r) * 256 + c2]; *(f32x2*)(o + (size_t)r * CD + 2 * c2) = (f32x2){bf_lo(v), bf_hi(v)}; }
    }
    { const int cp = tid & 255, half = tid >> 8;
      f32x2 acc[16];
#pragma unroll
      for (int o = 0; o < 16; ++o) acc[o] = bb;
      const LAS unsigned* ip = inb + (16 * half) * 256 + cp; unsigned vc = ip[0], vn = 0u;
#pragma unroll
      for (int i = 0; i < 46; ++i) { if (i + 1 < 46) vn = ip[(i + 1) * 256]; const f32x2 x = {bf_lo(vc), bf_hi(vc)};
#pragma unroll
          for (int o = 0; o < 16; ++o) { const int j = i - o; if (j >= 0 && j < CK) acc[o] += w[j] * x; }
          __builtin_amdgcn_sched_barrier(0); vc = vn; }
#pragma unroll
      for (int o = 0; o < 16; ++o) *(LAS f32x2*)(yb + (16 * half + o) * CD + 2 * cp) = acc[o];
    }
    __syncthreads();
    const f32x4 g0 = *(const f32x4*)(ln_g + lane * 8), g1 = *(const f32x4*)(ln_g + lane * 8 + 4), b0 = *(const f32x4*)(ln_b + lane * 8), b1 = *(const f32x4*)(ln_b + lane * 8 + 4);
#pragma unroll
    for (int rr = 0; rr < 4; ++rr) { const int row = wave * 4 + rr;
        f32x4 v0 = *(const LAS f32x4*)(yb + row * CD + lane * 8), v1 = *(const LAS f32x4*)(yb + row * CD + lane * 8 + 4);
        const float mu = wave_sum((v0[0] + v0[1]) + (v0[2] + v0[3]) + (v1[0] + v1[1]) + (v1[2] + v1[3])) * (1.f / CD);
        v0 = v0 - mu; v1 = v1 - mu;
        const float var = wave_sum((v0[0] * v0[0] + v0[1] * v0[1]) + (v0[2] * v0[2] + v0[3] * v0[3]) + (v1[0] * v1[0] + v1[1] * v1[1]) + (v1[2] * v1[2] + v1[3] * v1[3])) * (1.f / CD);
        const float rstd = rsqrtf(var + EPS);
        v0 = v0 * rstd * g0 + b0; v1 = v1 * rstd * g1 + b1;
#pragma unroll
        for (int e = 0; e < 4; ++e) { v0[e] *= sigm(v0[e]); v1[e] *= sigm(v1[e]); }
        *(u32x4*)(Y + (size_t)(tokbase + t0 + row) * CD + lane * 8) = pack8(v0, v1); }
    __syncthreads();
}

__device__ __forceinline__ int crow(int r, int hi) { return (r & 3) + 8 * (r >> 2) + 4 * hi; }
__device__ __forceinline__ float max3f(float a, float b, float c) { float r; asm("v_max3_f32 %0, %1, %2, %3" : "=v"(r) : "v"(a), "v"(b), "v"(c)); return r; }
__device__ __forceinline__ float max2f(float a, float b) { float r; asm("v_max_f32_e32 %0, %1, %2" : "=v"(r) : "v"(a), "v"(b)); return r; }
#define MFMA32(a, b, c) __builtin_amdgcn_mfma_f32_32x32x16_bf16((a), (b), (c), 0, 0, 0)
__device__ __forceinline__ void attn_unit(int wu, const bf16_t* Q, const bf16_t* K, const bf16_t* VT, bf16_t* O, const LAS float* rb, int lane) {
    const int r32 = lane & 31, hi = lane >> 5;
    int h, qtok0, jstart, cb, half;
    if (wu < 8192) { half = wu & 1; const int n = (wu >> 1) & 255; h = (wu >> 9) & 7; const int b = wu >> 12; qtok0 = b * TP + 64 * n + 32 * half; cb = b * 256 + n - 8; jstart = n < 8 ? 8 - n : 0; }
    else { const int w2 = wu - 8192; half = w2 & 1; h = (w2 >> 1) & 7; const int sb = w2 >> 4; qtok0 = NTP + sb * TS + 32 * half; cb = 512 + sb * 9; jstart = 0; }
    const bf16_t* Kt = K + ((size_t)(cb * NHEAD + h)) * 4096 + lane * 8; const bf16_t* Vt = VT + ((size_t)(cb * NHEAD + h)) * 4096 + lane * 8;
    bf16x8 qf[4];
    { const bf16_t* qp = Q + (size_t)(qtok0 + r32) * AD + h * HD + 8 * hi;
#pragma unroll
      for (int d0 = 0; d0 < 4; ++d0) qf[d0] = *(const bf16x8*)(qp + 16 * d0); }
    const int qi = 32 * half + r32; const LAS float* rbh = rb + h * 257;
    float mref = 0.f, l = 0.f; f32x16 o0 = {}, o1 = {}, negm = {};
    bf16x8 kf[2][8];
#pragma unroll
    for (int j = 0; j < 9; ++j) {
        if (j == jstart) {
#pragma unroll
            for (int i = 0; i < 8; ++i) kf[j & 1][i] = *(const bf16x8*)(Kt + (size_t)j * 32768 + i * 512);
        }
        if (j >= jstart) {
            const bool first = (j == jstart);
            bf16x8 vf[8];
#pragma unroll
            for (int i = 0; i < 8; ++i) vf[i] = *(const bf16x8*)(Vt + (size_t)j * 32768 + i * 512);
            if (j < 8) {
#pragma unroll
                for (int i = 0; i < 8; ++i) kf[(j + 1) & 1][i] = *(const bf16x8*)(Kt + (size_t)(j + 1) * 32768 + i * 512);
            }
            f32x16 p0, p1;
            p0 = MFMA32(kf[j & 1][0], qf[0], negm); p1 = MFMA32(kf[j & 1][4], qf[0], negm);
#pragma unroll
            for (int d0 = 1; d0 < 4; ++d0) { p0 = MFMA32(kf[j & 1][d0], qf[d0], p0); p1 = MFMA32(kf[j & 1][4 + d0], qf[d0], p1); }
            asm volatile("s_nop 15\n\ts_nop 7" : "+v"(p0), "+v"(p1));
            const int c = 8 - j;
            if (c < 3) { const int base = 64 * c + qi + 128;
#pragma unroll
                for (int i = 0; i < 16; ++i) { const int kv = crow(i, hi); const int i0 = base - kv, i1 = base - kv - 32; p0[i] += rbh[i0 > 256 ? 256 : i0]; p1[i] += rbh[i1 > 256 ? 256 : i1]; }
            }
            float ma = max3f(p0[0], p0[1], p1[0]), mb = max3f(p0[2], p0[3], p1[1]); ma = max3f(ma, p1[2], p1[3]);
#pragma unroll
            for (int i = 4; i < 16; i += 4) { ma = max3f(ma, p0[i], p0[i + 1]); mb = max3f(mb, p0[i + 2], p0[i + 3]); ma = max3f(ma, p1[i], p1[i + 1]); mb = max3f(mb, p1[i + 2], p1[i + 3]); }
            float mt = max2f(ma, mb); mt = max2f(mt, __shfl_xor(mt, 32));
            if (first || __any(mt > 8.f)) { const float dl = first ? mt : fmaxf(mt, 0.f), f = first ? 1.f : __builtin_amdgcn_exp2f(-dl); mref += dl; l *= f;
#pragma unroll
                for (int i = 0; i < 16; ++i) { o0[i] *= f; o1[i] *= f; p0[i] -= dl; p1[i] -= dl; negm[i] = -mref; } }
            float ls = 0.f;
#pragma unroll
            for (int i = 0; i < 16; ++i) { p0[i] = __builtin_amdgcn_exp2f(p0[i]); p1[i] = __builtin_amdgcn_exp2f(p1[i]); ls += p0[i] + p1[i]; }
            l += ls;
            u32x4 pw[4];
#pragma unroll
            for (int s2 = 0; s2 < 2; ++s2) { pw[s2] = (u32x4){pk2(p0[8 * s2], p0[8 * s2 + 1]), pk2(p0[8 * s2 + 2], p0[8 * s2 + 3]), pk2(p0[8 * s2 + 4], p0[8 * s2 + 5]), pk2(p0[8 * s2 + 6], p0[8 * s2 + 7])};
                                             pw[2 + s2] = (u32x4){pk2(p1[8 * s2], p1[8 * s2 + 1]), pk2(p1[8 * s2 + 2], p1[8 * s2 + 3]), pk2(p1[8 * s2 + 4], p1[8 * s2 + 5]), pk2(p1[8 * s2 + 6], p1[8 * s2 + 7])}; }
#pragma unroll
            for (int s2 = 0; s2 < 4; ++s2) { const bf16x8 pa = __builtin_bit_cast(bf16x8, pw[s2]); o0 = MFMA32(vf[s2], pa, o0); o1 = MFMA32(vf[4 + s2], pa, o1); }
        }
    }
    l += __shfl_xor(l, 32); const float inv = 1.f / l;
    bf16_t* op = O + (size_t)(qtok0 + r32) * AD + h * HD + 4 * hi;
#pragma unroll
    for (int g = 0; g < 4; ++g) {
        *(u32x2*)(op + 8 * g) = (u32x2){pk2(o0[4 * g] * inv, o0[4 * g + 1] * inv), pk2(o0[4 * g + 2] * inv, o0[4 * g + 3] * inv)};
        *(u32x2*)(op + 32 + 8 * g) = (u32x2){pk2(o1[4 * g] * inv, o1[4 * g + 1] * inv), pk2(o1[4 * g + 2] * inv, o1[4 * g + 3] * inv)}; }
}

#define XB_TMO      128
#define XB_XCNT(j)  (256  + 64 * (j))
#define XB_XSUB(j)  (1280 + 64 * (j))
#define XB_XGEN(j)  (2304 + 64 * (j))
#define XB_TOP      3328
#define XB_TOPGEN   3392
#define XCD_BAR_WORDS 3456
#define XB_SPIN_CAP (1u << 18)

__device__ __forceinline__ unsigned xb_ld(unsigned* p)              { return __hip_atomic_load(p, __ATOMIC_RELAXED, __HIP_MEMORY_SCOPE_AGENT); }
__device__ __forceinline__ unsigned xb_add(unsigned* p, unsigned v) { return __hip_atomic_fetch_add(p, v, __ATOMIC_RELAXED, __HIP_MEMORY_SCOPE_AGENT); }
__device__ __forceinline__ unsigned xb_xcc_id() { return (unsigned)__builtin_amdgcn_s_getreg((3 << 11) | 20) & 0xFu; }
#define XB_SPIN(cond, bar) do { unsigned _sp = 0; while (cond) { __builtin_amdgcn_s_sleep(1); \
    if ((++_sp & 255u) == 0u) { if (xb_ld(&(bar)[XB_TMO])) break; if (_sp > XB_SPIN_CAP) { atomicAdd(&(bar)[XB_TMO], 1u); break; } } } } while (0)

struct XcdBarrier {
    unsigned* bar; unsigned x;
    volatile LAS unsigned* st;
};

__device__ __forceinline__ XcdBarrier xcd_barrier_post(unsigned* bar, volatile LAS unsigned* st) {
    XcdBarrier b; b.bar = bar; b.x = xb_xcc_id(); b.st = st;
    if (threadIdx.x == 0) (void)xb_add(&bar[XB_XCNT(b.x)], 1u);
    return b;
}
__device__ __forceinline__ void xcd_barrier_complete(unsigned* bar, unsigned x, unsigned& nloc, unsigned& nx) {
    const unsigned G = gridDim.x * gridDim.y * gridDim.z;
    unsigned sum, cnt, mine, sp = 0u;
    for (;;) {
        sum = 0u; cnt = 0u; mine = 0u;
#pragma unroll
        for (unsigned j = 0; j < 16; ++j) { const unsigned c = xb_ld(&bar[XB_XCNT(j)]); sum += c; cnt += (c > 0u) ? 1u : 0u; mine = (j == x) ? c : mine; }
        if (sum == G) break;
        __builtin_amdgcn_s_sleep(1);
        if ((++sp & 255u) == 0u) { if (xb_ld(&bar[XB_TMO])) break; if (sp > XB_SPIN_CAP) { atomicAdd(&bar[XB_TMO], 1u); break; } }
    }
    nloc = mine > 0u ? mine : 1u; nx = cnt > 0u ? cnt : 1u;
}

__device__ __forceinline__ void xcd_barrier(const XcdBarrier& b) {
    asm volatile("s_waitcnt vmcnt(0)" ::: "memory");
    __syncthreads();
    if (threadIdx.x == 0) {
        unsigned* bar = b.bar;
        __builtin_amdgcn_s_waitcnt(0);
        unsigned nloc = b.st[0], nx = b.st[1];
        if (nloc == 0u) { xcd_barrier_complete(bar, b.x, nloc, nx); b.st[0] = nloc; b.st[1] = nx; }
        const unsigned old = xb_add(&bar[XB_XSUB(b.x)], 1u);
        const unsigned gen = old / nloc;
        if (old + 1u == (gen + 1u) * nloc) {
            __builtin_amdgcn_fence(__ATOMIC_RELEASE, "agent");
            asm volatile("s_waitcnt vmcnt(0)" ::: "memory");
            const unsigned og = xb_add(&bar[XB_TOP], 1u);
            const unsigned tg = og / nx;
            if (og + 1u == (tg + 1u) * nx) xb_add(&bar[XB_TOPGEN], 1u);
            else XB_SPIN(xb_ld(&bar[XB_TOPGEN]) == tg, bar);
            __builtin_amdgcn_fence(__ATOMIC_ACQUIRE, "agent");
            xb_add(&bar[XB_XGEN(b.x)], 1u);
            asm volatile("s_waitcnt vmcnt(0)" ::: "memory");
        } else {
            XB_SPIN(xb_ld(&bar[XB_XGEN(b.x)]) == gen, bar);
            __builtin_amdgcn_fence(__ATOMIC_ACQUIRE, "agent");
            asm volatile("s_waitcnt vmcnt(0)" ::: "memory");
        }
    }
    __syncthreads();
}

struct Args { const float* in[24]; float* out; unsigned char* ws; int ph_lo, ph_hi; };
enum { I_XP = 0, I_XS, I_CP, I_CS, I_CCONV, I_CK, I_CV, I_N1G, I_N2G, I_WADA, I_BADA, I_WIN, I_WDW, I_BDW, I_LNG, I_LNB, I_WCO, I_QG, I_KG, I_RB, I_WAO, I_WO, I_WF1, I_WF2 };
constexpr int NPHASE = 8;

__global__ void __launch_bounds__(NTHREADS, 2) fwd_mega(Args a) {
    extern __shared__ __attribute__((aligned(16))) unsigned char lds_raw[];
    LAS unsigned char* lds = (LAS unsigned char*)lds_raw;
    cg::grid_group grid = cg::this_grid();
    const int tid = threadIdx.x, lane = tid & 63, wave = __builtin_amdgcn_readfirstlane(tid >> 6);
    const int G = gridDim.x, bx = blockIdx.x;
    const int vcu = (G % 8 == 0) ? (bx % 8) * (G / 8) + bx / 8 : bx;
    const int gw = vcu * NWAVES + wave, NGW = G * NWAVES;
    unsigned char* ws = a.ws; float* out = a.out;
    float* MOD = (float*)(ws + WS_MOD); float* CVEC = (float*)(ws + WS_CVEC); float* SS = (float*)(ws + WS_SS);
    bf16_t *WC = (bf16_t*)(ws + WS_WC), *WA = (bf16_t*)(ws + WS_WA), *WO = (bf16_t*)(ws + WS_WO), *WF1 = (bf16_t*)(ws + WS_WF1), *WF2 = (bf16_t*)(ws + WS_WF2), *WIN = (bf16_t*)(ws + WS_WIN), *WV = (bf16_t*)(ws + WS_WV);
    bf16_t *H = (bf16_t*)(ws + WS_H), *U = (bf16_t*)(ws + WS_U), *Q = (bf16_t*)(ws + WS_Q), *KB = (bf16_t*)(ws + WS_K), *VT = (bf16_t*)(ws + WS_VT), *SG = (bf16_t*)(ws + WS_SG);
    bf16_t *Y = (bf16_t*)(ws + WS_Y), *O = (bf16_t*)(ws + WS_O), *M1 = (bf16_t*)(ws + WS_M1), *MG = (bf16_t*)(ws + WS_MG), *A2 = (bf16_t*)(ws + WS_A2), *ACT = (bf16_t*)(ws + WS_ACT);
    const int lo = a.ph_lo, hi = a.ph_hi;
    unsigned* barw = (unsigned*)(ws + WS_BAR);
    volatile LAS unsigned* bst = (volatile LAS unsigned*)(lds + LDS_BYTES - 64);
    if (tid < 2) bst[tid] = 0u;
    __syncthreads();
    XcdBarrier xbar = xcd_barrier_post(barw, bst);
    if (lo < 0) grid.sync();
#define IN(k) (lo <= (k) && (k) < hi)
#define SEAM(k) do { if (IN(k) && IN((k) + 1)) xcd_barrier(xbar); } while (0)
#ifndef PROBE_MASK
#define PROBE_MASK 0
#endif
#define REPS(k) ((((PROBE_MASK) >> (k)) & 1) + 1)
#define REPSYNC(k) do { if (rep + 1 < REPS(k)) xcd_barrier(xbar); } while (0)

    if (IN(0)) for (int rep = 0; rep < REPS(0); ++rep) {
        for (int task = bx; task < 6144 / 32; task += G) gemv34<0>(lds, task, a.in[I_WADA], 6144, a.in[I_BADA], MOD, a.in[I_CP], a.in[I_CS], nullptr, tid, lane, wave);
        LAS float* scr = (LAS float*)(lds + wave * 16640);
        constexpr int I1 = 16 * 72, I2 = 8 * 16, I3 = 8 * 16, I4 = 16 * 16, I5 = 16 * 88, I6 = 44 * 16, I7 = 32 * 8 * 8, NIT = I1 + I2 + I3 + I4 + I5 + I6 + I7;
        for (int it = gw; it < NIT; it += NGW) { int r = it;
            if (r < I1) { const int kb = r / 72, nb = r % 72, dA = win_dest(nb * 64), dB = win_dest(nb * 64 + 32);
                if (dA >= 0) tr_item(a.in[I_WIN], NIN, kb * 64, nb * 64, WIN, DM, dA, dB, scr, lane); else tr_item(a.in[I_WIN], NIN, kb * 64, nb * 64, WV, DM, -dA - 1, -dB - 1, scr, lane); continue; } r -= I1;
            if (r < I2) { tr_item(a.in[I_WCO], DM, (r / 16) * 64, (r % 16) * 64, WC, CD, (r % 16) * 64, (r % 16) * 64 + 32, scr, lane); continue; } r -= I2;
            if (r < I3) { tr_item(a.in[I_WAO], DM, (r / 16) * 64, (r % 16) * 64, WA, AD, (r % 16) * 64, (r % 16) * 64 + 32, scr, lane); continue; } r -= I3;
            if (r < I4) { tr_item(a.in[I_WO], DM, (r / 16) * 64, (r % 16) * 64, WO, DM, (r % 16) * 64, (r % 16) * 64 + 32, scr, lane); continue; } r -= I4;
            if (r < I5) { const int kb = r / 88, nb = r % 88; tr_item(a.in[I_WF1], 2 * FF, kb * 64, nb * 64, WF1, DM, ffn_dest(nb * 64), ffn_dest(nb * 64 + 32), scr, lane); continue; } r -= I5;
            if (r < I6) { tr_item(a.in[I_WF2], DM, (r / 16) * 64, (r % 16) * 64, WF2, FF, (r % 16) * 64, (r % 16) * 64 + 32, scr, lane); continue; } r -= I6;
            { const int sb = r >> 6, cc = (r >> 3) & 7, hh = r & 7;
              const float* src = a.in[I_CV] + ((size_t)sb * BANDP + cc * 64) * AD + hh * HD + (lane & 31); bf16_t* dst = VT + ((size_t)((512 + sb * 9 + cc) * NHEAD + hh)) * 4096 + lane * 8; const int hi4 = (lane >> 5) * 4;
#pragma unroll
              for (int db = 0; db < 2; ++db)
#pragma unroll
                  for (int s4 = 0; s4 < 4; ++s4) { float v[8];
#pragma unroll
                      for (int j = 0; j < 8; ++j) v[j] = src[(size_t)(16 * s4 + 8 * (j >> 2) + hi4 + (j & 3)) * AD + 32 * db];
                      *(u32x4*)(dst + (db * 4 + s4) * 512) = (u32x4){pk2(v[0], v[1]), pk2(v[2], v[3]), pk2(v[4], v[5]), pk2(v[6], v[7])}; } }
        }
#pragma unroll 4
        for (int r = gw; r < NBS * BANDP; r += NGW) { const int sb = r >> 9, i = r & 511; const float* sp = a.in[I_CK] + (size_t)r * AD + lane * 8; const int kidx = NTP + sb * SKV + i;
            *(u32x4*)(KB + ((size_t)((kidx >> 6) * NHEAD + (lane >> 3)) * 8 + ((kidx >> 5) & 1) * 4 + ((lane & 7) >> 1)) * 512 + ((lane & 1) * 32 + (kidx & 31)) * 8) = pack8(*(const f32x4*)sp, *(const f32x4*)(sp + 4)); }
        REPSYNC(0);
    }
    SEAM(0);
    if ((PROBE_MASK >> 9) & 1) { for (int e = 0; e < 8; ++e) xcd_barrier(xbar); }
    if (IN(1)) for (int rep = 0; rep < REPS(1); ++rep) {
        for (int task = bx; task < (2 * FF) / 32; task += G) gemv34<1>(lds, task, a.in[I_WF1], 2 * FF, nullptr, CVEC, nullptr, nullptr, MOD, tid, lane, wave);
        const float* g1 = a.in[I_N1G];
        const bool bal = (G == 256); constexpr int NGV = 176 * NWAVES, NG1 = 4 * NGV;
        const int gstart = !bal ? gw : (bx < 176 ? bx * NWAVES + wave : NG1 + (bx - 176) * NWAVES + wave), gstep = !bal ? NGW : (bx < 176 ? NGV : (256 - 176) * NWAVES), gend = (bal && bx < 176) ? NG1 : NTOK / 4;
        for (int g4 = gstart; g4 < gend; g4 += gstep) { const int row0 = 4 * g4; const float* xr = row0 < NTP ? a.in[I_XP] + (size_t)row0 * DM : a.in[I_XS] + (size_t)(row0 - NTP) * DM; const float* mb = MOD + (size_t)bid_of(row0) * 6144;
            f32x4 v[4][4];
#pragma unroll
            for (int r = 0; r < 4; ++r)
#pragma unroll
                for (int j = 0; j < 4; ++j) v[r][j] = *(const f32x4*)(xr + (size_t)r * DM + 4 * lane + 256 * j);
            f32x4 gm[4], sh[4];
#pragma unroll
            for (int j = 0; j < 4; ++j) { const int col = 4 * lane + 256 * j; gm[j] = *(const f32x4*)(g1 + col) * (*(const f32x4*)(mb + 1024 + col) + 1.f); sh[j] = *(const f32x4*)(mb + col); }
#pragma unroll
            for (int r = 0; r < 4; ++r) { float ss = 0.f;
#pragma unroll
                for (int j = 0; j < 4; ++j) ss += (v[r][j][0] * v[r][j][0] + v[r][j][1] * v[r][j][1]) + (v[r][j][2] * v[r][j][2] + v[r][j][3] * v[r][j][3]);
                const float rstd = rsqrtf(wave_sum(ss) * (1.f / DM) + EPS);
#pragma unroll
                for (int j = 0; j < 4; ++j) { const f32x4 hh = v[r][j] * rstd * gm[j] + sh[j];
                    *(u32x2*)(H + (size_t)(row0 + r) * DM + 4 * lane + 256 * j) = (u32x2){pk2(hh[0], hh[1]), pk2(hh[2], hh[3])}; } } }
        REPSYNC(1);
    }
    SEAM(1);
    if (IN(2)) for (int rep = 0; rep < REPS(2); ++rep) {
        pg8::Gemm g{WIN, WIN, NTOK, 4096, DM}; OrderIn S; S.init(G, bx);
        EpiIn E{U, Q, KB, VT, SG, out, a.in[I_QG], a.in[I_KG]};
        pg8::gemm_phase<EpiIn, OrderIn, true, true>(lds, g, S, E);
        REPSYNC(2);
    }
    SEAM(2);
    if (IN(3)) {
        const bool cbal = (G == 256); const int cfirst = !cbal ? bx : (vcu < 64 ? 960 + vcu : vcu - 64), cstep = !cbal ? G : (vcu < 64 ? 64 : 192), cend = (cbal && vcu >= 64) ? 960 : 1024 + 64;
        for (int rep = 0; rep < REPS(3); ++rep)
        { f32x2 cw[CK];
#pragma unroll
          for (int j = 0; j < CK; ++j) cw[j] = *(const f32x2*)(a.in[I_WDW] + j * CD + 2 * (tid & 255));
          const f32x2 cbb = *(const f32x2*)(a.in[I_BDW] + 2 * (tid & 255));
        for (int cu = cfirst; cu < cend; cu += cstep) conv_unit(cu, lds, U, a.in[I_CCONV], cw, cbb, a.in[I_LNG], a.in[I_LNB], Y, out, tid, lane, wave); }
        LAS float* rb = (LAS float*)lds;
        for (int idx = tid; idx < NHEAD * 257; idx += NTHREADS) rb[idx] = (a.in[I_RB][idx] - a.in[I_RB][(idx / 257) * 257 + 256]) * LOG2E;
        __syncthreads();
        for (int rep = 0; rep < REPS(8); ++rep)
        for (int wu = gw; wu < 8192 + 512; wu += NGW) attn_unit(wu, Q, KB, VT, O, rb, lane);
        __syncthreads();
    }
    SEAM(3);
    if (IN(4)) for (int rep = 0; rep < REPS(4); ++rep) {
        static_assert(WS_O - WS_Y == (size_t)NROWT * 256 * CD * 2 && WS_WA - WS_WC == (size_t)4 * 256 * CD * 2, "concatenated [Y | O] and [Wc | Wa] tile spaces");
        PairOrder S; S.init(NTOK, DM, G, bx); pg8::Gemm g{Y, WC, NTOK, DM, CD}; EpiMergeFused E{SG, MG};
        pg8::gemm_phase<EpiMergeFused, PairOrder, true, true>(lds, g, S, E);
        REPSYNC(4);
    }
    SEAM(4);
    if (IN(5)) for (int rep = 0; rep < REPS(5); ++rep) {
        pg8::TailOrder S; S.init(NTOK, DM, G, bx); pg8::Gemm g{MG, WO, NTOK, DM, DM};
        EpiX1 E{a.in[I_XP], a.in[I_XS], MOD, a.in[I_N2G], (bf16_t*)(ws + WS_X1), A2, SS};
        pg8::gemm_phase<EpiX1, pg8::TailOrder, true, true>(lds, g, S, E);
        REPSYNC(5);
    }
    SEAM(5);
    if (IN(6)) for (int rep = 0; rep < REPS(6); ++rep) {
        pg8::StaticOrder S; S.init(NTOK, 2 * FF, G, bx); pg8::Gemm g{A2, WF1, NTOK, 2 * FF, DM};
        EpiFfn E{SS, CVEC, ACT};
        pg8::gemm_phase<EpiFfn, pg8::StaticOrder, true, true>(lds, g, S, E);
        REPSYNC(6);
    }
    SEAM(6);
    if (IN(7)) {
        pg8::TailOrder S; S.init(NTOK, DM, G, bx); pg8::Gemm g{ACT, WF2, NTOK, DM, FF};
        EpiOut E{MOD, (const bf16_t*)(ws + WS_X1), out + OUT_Y};
        pg8::gemm_phase<EpiOut, pg8::TailOrder, true, true>(lds, g, S, E);
    }
#undef IN
#undef SEAM
}

#ifndef MK_SPLIT
#define MK_SPLIT 0
#endif
extern "C" void kernel_launch(void* const* d_in, const int* in_sizes, int n_in, void* d_out, int out_size, void* d_ws, size_t ws_size, hipStream_t stream) {
    static int grid = 0;
    if (grid == 0) {
        if (n_in != 24 || out_size != (int)OUT_END || ws_size < WS_END) { fprintf(stderr, "kernel_launch: unexpected problem (n_in %d, out %d, ws %zu)\n", n_in, out_size, ws_size); grid = -1; return; }
        int dev = 0, cus = 0, per_cu = 0;
        hipGetDevice(&dev); hipDeviceGetAttribute(&cus, hipDeviceAttributeMultiprocessorCount, dev);
        hipFuncSetAttribute((const void*)fwd_mega, hipFuncAttributeMaxDynamicSharedMemorySize, LDS_BYTES);
        hipOccupancyMaxActiveBlocksPerMultiprocessor(&per_cu, (const void*)fwd_mega, NTHREADS, LDS_BYTES);
        if (per_cu < 1) { fprintf(stderr, "kernel_launch: occupancy query says %d blocks per CU\n", per_cu); grid = -1; return; }
        grid = cus * 1;
    }
    if (grid < 0) return;
    Args a{};
    for (int i = 0; i < 24; ++i) a.in[i] = (const float*)d_in[i];
    a.out = (float*)d_out; a.ws = (unsigned char*)d_ws;
#if MK_SPLIT
    for (int p = 0; p < NPHASE; ++p) { a.ph_lo = p; a.ph_hi = p + 1; void* args[] = {&a};
        hipError_t e = hipLaunchCooperativeKernel((const void*)fwd_mega, dim3(grid), dim3(NTHREADS), args, LDS_BYTES, stream);
        if (e != hipSuccess) { fprintf(stderr, "launch %d failed: %s\n", p, hipGetErrorString(e)); break; } }
#else
    if (hipMemsetAsync((char*)d_ws + WS_BAR, 0, 16384, stream) != hipSuccess) { fprintf(stderr, "kernel_launch: memset of the barrier words failed\n"); return; }
    a.ph_lo = 0; a.ph_hi = NPHASE; void* args[] = {&a};
    hipError_t e = hipLaunchCooperativeKernel((const void*)fwd_mega, dim3(grid), dim3(NTHREADS), args, LDS_BYTES, stream);
    if (e != hipSuccess) fprintf(stderr, "cooperative launch failed: %s (grid %d)\n", hipGetErrorString(e), grid);
#endif
}
```

```cpp
#include <hip/hip_runtime.h>
#include <hip/hip_cooperative_groups.h>
#include <cstdio>
#include <cstdint>
namespace cg = cooperative_groups;
namespace pg8 {
#define PG8_LAS __attribute__((address_space(3)))
typedef unsigned short bf16_t;
typedef short bf16x8 __attribute__((ext_vector_type(8)));
typedef float f32x4 __attribute__((ext_vector_type(4)));
typedef unsigned u32x4 __attribute__((ext_vector_type(4)));
constexpr int BM = 256, BK = 64, HALF = 128, HTB = HALF * BK * 2  , STAGE_BYTES = 8 * HTB, NXCD = 8, WGM = 8;

__host__ __device__ __forceinline__ int lds_byte(int r, int c) { const int st = (r >> 4) * 2 + (c >> 5), rr = r & 15, cc = c & 31, ob = rr * 64 + cc * 2; return st * 1024 + (ob ^ (((ob >> 9) & 1) << 5)); }
__host__ __device__ __forceinline__ void stage_rc(int b, int& R, int& C) { const int st = b / 1024, sb = b % 1024, swz = sb ^ (((sb >> 9) & 1) << 5); R = (st >> 1) * 16 + swz / 64; C = (st & 1) * 32 + (swz % 64) / 2; }
__host__ __device__ __forceinline__ int perm32(int rho) { const int n = rho >> 4, i = rho & 15; return 8 * (i >> 2) + 4 * n + (i & 3); }

struct Unit { int pm, pn, sub; };
struct Gemm { const bf16_t* A; const bf16_t* Bt; int M, N, K; };

struct StaticOrder {
    int nM, nN, nwg, G, c;
    __host__ __device__ void init(int M, int N, int G_, int c_) { nM = M / BM; nN = N / BM; nwg = nM * nN; G = G_; c = c_; }
    __host__ __device__ void map(int L, Unit& u) const {
        int wgid = L; { const int q = nwg / NXCD, r = nwg % NXCD, xcd = wgid % NXCD, off = wgid / NXCD; wgid = (xcd < r ? xcd * (q + 1) : r * (q + 1) + (xcd - r) * q) + off; }
        const int nig = WGM * nN, gid = wgid / nig, fm = gid * WGM, gsz = (nM - fm) < WGM ? (nM - fm) : WGM;
        u.pm = fm + ((wgid % nig) % gsz); u.pn = (wgid % nig) / gsz; u.sub = -1;
    }
    __host__ __device__ bool next(int i, Unit& u) const { const long L = (long)i * G + c; if (L >= nwg) return false; map((int)L, u); return true; }
    __device__ __forceinline__ void a_ready(const Unit&) const {}
    __device__ __forceinline__ void done(const Unit&) const {}
};

struct TailOrder {
    StaticOrder so; int nfull;
    __host__ __device__ void init(int M, int N, int G_, int c_) { so.init(M, N, G_, c_); nfull = (so.nwg / G_) * G_; }
    __host__ __device__ bool next(int i, Unit& u) const {
        const long L = (long)i * so.G + so.c;
        if (L < nfull) { so.map((int)L, u); return true; }
        const long Lq = L - nfull; if (Lq >= 4L * (so.nwg - nfull)) return false;
        so.map(nfull + (int)(Lq >> 2), u); u.sub = (int)(Lq & 3); return true;
    }
    __device__ __forceinline__ void a_ready(const Unit&) const {}
    __device__ __forceinline__ void done(const Unit&) const {}
};

__device__ __forceinline__ unsigned cvt_pk_bf16(float lo, float hi) { unsigned r; asm volatile("v_cvt_pk_bf16_f32 %0, %1, %2" : "=v"(r) : "v"(lo), "v"(hi)); return r; }
typedef float f32x2 __attribute__((ext_vector_type(2)));
template <class Epi, class Sched, bool ALIGN_EPI = false, bool SP2 = false>
__device__ __forceinline__ void gemm_phase(PG8_LAS unsigned char* lds, const Gemm g, const Sched& S, const Epi& E) {
    const int tid = threadIdx.x, wid = __builtin_amdgcn_readfirstlane(tid >> 6), lane = tid & 63, wr = wid >> 2, wc = wid & 3, fr = lane & 15, fq = lane >> 4;
    const int K = g.K, nt = K / BK;
    unsigned voffA[2], voffB[2];
#pragma unroll
    for (int i = 0; i < 2; ++i) { int R, C; stage_rc(tid * 16 + i * 8192, R, C); const int Rb = Epi::PERM ? ((R & ~31) + perm32(R & 31)) : R;
        voffA[i] = (unsigned)(R * K + C) * 2u; voffB[i] = (unsigned)(Rb * K + C) * 2u; }
    const size_t kstep = (size_t)(BK * 2);
    const size_t hstep = (size_t)HALF * K * 2;
    const size_t tstep = 2 * hstep;
    const unsigned ldsw = (unsigned)wid * 1024u;
    const int aoff = lds_byte(wr * 64 + fr, fq * 8), boff = lds_byte(wc * 32 + fr, fq * 8);
#define PG8_SA(b, h) (((b) * 2 + (h)) * HTB)
#define PG8_SB(b, h) ((4 + (b) * 2 + (h)) * HTB)
#define PG8_STAGE(bufoff, gbase, voff) do { _Pragma("unroll") for (int _i = 0; _i < 2; ++_i) \
        __builtin_amdgcn_global_load_lds((const unsigned*)((const char*)(gbase) + (voff)[_i]), (PG8_LAS unsigned*)(lds + (bufoff) + ldsw + _i * 8192), 16, 0, 0); } while (0)
#define PG8_LDA(dst, b, h) do { _Pragma("unroll") for (int m = 0; m < 4; ++m) _Pragma("unroll") for (int k = 0; k < 2; ++k) dst[m][k] = *(const PG8_LAS bf16x8*)(lds + PG8_SA(b, h) + aoff + m * 2048 + k * 1024); } while (0)
#define PG8_LDB(dst, b, h) do { _Pragma("unroll") for (int n = 0; n < 2; ++n) _Pragma("unroll") for (int k = 0; k < 2; ++k) dst[n][k] = *(const PG8_LAS bf16x8*)(lds + PG8_SB(b, h) + boff + n * 2048 + k * 1024); } while (0)
#define PG8_MMA(ai, bj, At, Bt) do { __builtin_amdgcn_s_setprio(1); _Pragma("unroll") for (int m = 0; m < 4; ++m) _Pragma("unroll") for (int n = 0; n < 2; ++n) _Pragma("unroll") for (int k = 0; k < 2; ++k) \
        acc[ai][bj][m][n] = __builtin_amdgcn_mfma_f32_16x16x32_bf16(Bt[n][k], At[m][k], acc[ai][bj][m][n], 0, 0, 0); __builtin_amdgcn_s_setprio(0); } while (0)
#define PG8_WAIT_V(n) asm volatile("s_waitcnt vmcnt(" #n ")" ::: "memory")
#define PG8_WAIT_L(n) asm volatile("s_waitcnt lgkmcnt(" #n ")" ::: "memory")
#define PG8_BAR __builtin_amdgcn_s_barrier()
#define PG8_SCHED __builtin_amdgcn_sched_barrier(0)
    Unit cur, nxt; int ui = 0;
    if (!S.next(0, cur)) return;
    f32x4 acc[2][2][4][2];
#pragma unroll
    for (int a = 0; a < 2; ++a)
#pragma unroll
        for (int b = 0; b < 2; ++b)
#pragma unroll
            for (int m = 0; m < 4; ++m)
#pragma unroll
                for (int n = 0; n < 2; ++n) acc[a][b][m][n] = (f32x4){0.f, 0.f, 0.f, 0.f};
    bf16x8 At[4][2], B0[2][2], B1[2][2];
#define PG8_AOFF(u) ((u).sub >= 2 ? hstep : (size_t)0)
#define PG8_BOFF(u) (((u).sub >= 0 && ((u).sub & 1)) ? hstep : (size_t)0)
    const char* cA = (const char*)g.A + (size_t)cur.pm * tstep + PG8_AOFF(cur); const char* cB = (const char*)g.Bt + (size_t)cur.pn * tstep + PG8_BOFF(cur);
    S.a_ready(cur);
    if constexpr (SP2) {
        PG8_STAGE(PG8_SB(0, 0), cB, voffB); PG8_STAGE(PG8_SB(0, 1), cB + hstep, voffB); PG8_STAGE(PG8_SA(0, 0), cA, voffA); PG8_STAGE(PG8_SA(0, 1), cA + hstep, voffA);
        if (wr == 1) PG8_BAR;
        PG8_WAIT_V(2); PG8_BAR;
        PG8_STAGE(PG8_SB(1, 0), cB + kstep, voffB); PG8_STAGE(PG8_SA(1, 0), cA + kstep, voffA); PG8_STAGE(PG8_SB(1, 1), cB + hstep + kstep, voffB);
        PG8_WAIT_V(6); PG8_BAR;
    } else {
        PG8_STAGE(PG8_SB(0, 0), cB, voffB); PG8_STAGE(PG8_SA(0, 0), cA, voffA); PG8_STAGE(PG8_SB(0, 1), cB + hstep, voffB); PG8_STAGE(PG8_SA(0, 1), cA + hstep, voffA);
        if (wr == 1) PG8_BAR;
        PG8_WAIT_V(4); PG8_BAR;
        PG8_STAGE(PG8_SB(1, 0), cB + kstep, voffB); PG8_STAGE(PG8_SA(1, 0), cA + kstep, voffA); PG8_STAGE(PG8_SB(1, 1), cB + hstep + kstep, voffB);
        PG8_WAIT_V(6); PG8_BAR;
    }
    for (;;) {
        const bool has_next = S.next(ui + 1, nxt);
        const char* nA = has_next ? (const char*)g.A + (size_t)nxt.pm * tstep + PG8_AOFF(nxt) : cA; const char* nB = has_next ? (const char*)g.Bt + (size_t)nxt.pn * tstep + PG8_BOFF(nxt) : cB;
        const bool full = cur.sub < 0;
        for (int t = 0; t < nt; t += 2) {
            const bool last = (t == nt - 2);
            const char* a1 = cA + (size_t)(t + 1) * kstep;
            const char* a2 = last ? nA : cA + (size_t)(t + 2) * kstep; const char* b2 = last ? nB : cB + (size_t)(t + 2) * kstep;
            const char* a3 = a2 + kstep; const char* b3 = b2 + kstep;
            if (last && has_next) S.a_ready(nxt);
            if constexpr (SP2) {
            PG8_LDB(B0, 0, 0); PG8_LDB(B1, 0, 1); PG8_SCHED; PG8_LDA(At, 0, 0); PG8_STAGE(PG8_SA(1, 1), a1 + hstep, voffA);
            PG8_WAIT_V(8); PG8_WAIT_L(0); PG8_BAR; PG8_MMA(0, 0, At, B0); if (full) PG8_MMA(0, 1, At, B1); PG8_BAR; PG8_SCHED;
            PG8_LDA(At, 0, 1); PG8_STAGE(PG8_SB(0, 0), b2, voffB); PG8_STAGE(PG8_SB(0, 1), b2 + hstep, voffB); PG8_STAGE(PG8_SA(0, 0), a2, voffA);
            PG8_WAIT_V(8); PG8_WAIT_L(0); PG8_BAR; if (full) { PG8_MMA(1, 0, At, B0); PG8_MMA(1, 1, At, B1); } PG8_BAR; PG8_SCHED;
            PG8_LDB(B0, 1, 0); PG8_LDB(B1, 1, 1); PG8_SCHED; PG8_LDA(At, 1, 0); PG8_STAGE(PG8_SA(0, 1), a2 + hstep, voffA);
            PG8_WAIT_V(8); PG8_WAIT_L(0); PG8_BAR; PG8_MMA(0, 0, At, B0); if (full) PG8_MMA(0, 1, At, B1); PG8_BAR; PG8_SCHED;
            PG8_LDA(At, 1, 1); PG8_STAGE(PG8_SB(1, 0), b3, voffB); PG8_STAGE(PG8_SB(1, 1), b3 + hstep, voffB); PG8_STAGE(PG8_SA(1, 0), a3, voffA);
            PG8_WAIT_V(8); PG8_WAIT_L(0); PG8_BAR; if (full) { PG8_MMA(1, 0, At, B0); PG8_MMA(1, 1, At, B1); } PG8_BAR; PG8_SCHED;
            } else {
            PG8_LDB(B0, 0, 0); PG8_SCHED; PG8_LDA(At, 0, 0); PG8_STAGE(PG8_SA(1, 1), a1 + hstep, voffA);
            PG8_WAIT_L(8); PG8_BAR; PG8_WAIT_L(0); PG8_MMA(0, 0, At, B0); PG8_BAR; PG8_SCHED;
            PG8_LDB(B1, 0, 1); PG8_STAGE(PG8_SB(0, 0), b2, voffB);
            PG8_BAR; PG8_WAIT_L(0); PG8_MMA(0, 1, At, B1); PG8_BAR;
            PG8_LDA(At, 0, 1); PG8_STAGE(PG8_SA(0, 0), a2, voffA);
            PG8_BAR; PG8_WAIT_L(0); PG8_MMA(1, 0, At, B0); PG8_BAR; PG8_SCHED;
            PG8_STAGE(PG8_SB(0, 1), b2 + hstep, voffB);
            PG8_WAIT_V(6); PG8_BAR; PG8_MMA(1, 1, At, B1); PG8_BAR;
            PG8_LDB(B0, 1, 0); PG8_SCHED; PG8_LDA(At, 1, 0); PG8_STAGE(PG8_SA(0, 1), a2 + hstep, voffA);
            PG8_WAIT_L(8); PG8_BAR; PG8_WAIT_L(0); PG8_MMA(0, 0, At, B0); PG8_BAR; PG8_SCHED;
            PG8_LDB(B1, 1, 1); PG8_STAGE(PG8_SB(1, 0), b3, voffB);
            PG8_BAR; PG8_WAIT_L(0); PG8_MMA(0, 1, At, B1); PG8_BAR;
            PG8_LDA(At, 1, 1); PG8_STAGE(PG8_SA(1, 0), a3, voffA);
            PG8_BAR; PG8_WAIT_L(0); PG8_MMA(1, 0, At, B0); PG8_BAR; PG8_SCHED;
            PG8_STAGE(PG8_SB(1, 1), b3 + hstep, voffB);
            PG8_WAIT_V(6); PG8_BAR; PG8_MMA(1, 1, At, B1); PG8_BAR;
            }
        }
        if constexpr (ALIGN_EPI) { if (wr == 0) PG8_BAR; }
        if constexpr (!Epi::AFTER_DRAIN) { E(acc, cur, wr, wc, fr, fq); S.done(cur); }
        if (!has_next) break;
        if (!E.keep_acc(cur)) {
#pragma unroll
        for (int a = 0; a < 2; ++a)
#pragma unroll
            for (int b = 0; b < 2; ++b)
#pragma unroll
                for (int m = 0; m < 4; ++m)
#pragma unroll
                    for (int n = 0; n < 2; ++n) acc[a][b][m][n] = (f32x4){0.f, 0.f, 0.f, 0.f};
        }
        cur = nxt; cA = nA; cB = nB; ++ui;
        if constexpr (ALIGN_EPI) { if (wr == 1) PG8_BAR; }
    }
    PG8_WAIT_V(0);
    if constexpr (!ALIGN_EPI) { if (wr == 0) PG8_BAR; }
    PG8_BAR;
    if constexpr (Epi::AFTER_DRAIN) { E.fused(acc, cur, wr, wc, fr, fq, lds, wid, lane); S.done(cur); }
#undef PG8_AOFF
#undef PG8_BOFF
#undef PG8_SA
#undef PG8_SB
#undef PG8_STAGE
#undef PG8_LDA
#undef PG8_LDB
#undef PG8_MMA
#undef PG8_WAIT_V
#undef PG8_WAIT_L
#undef PG8_BAR
#undef PG8_SCHED
}
}

#define LAS __attribute__((address_space(3)))
typedef unsigned short bf16_t;
typedef float f32x4 __attribute__((ext_vector_type(4)));
typedef float f32x2 __attribute__((ext_vector_type(2)));
typedef float f32x16 __attribute__((ext_vector_type(16)));
typedef short bf16x8 __attribute__((ext_vector_type(8)));
typedef short s16x4 __attribute__((ext_vector_type(4)));
typedef unsigned u32x4 __attribute__((ext_vector_type(4)));
typedef unsigned u32x2 __attribute__((ext_vector_type(2)));

constexpr int DM = 1024, TP = 16384, NBP = 2, NBS = 32, TS = 64;
constexpr int NTP = NBP * TP, NTS = NBS * TS, NTOK = NTP + NTS;
constexpr int NB = NBP + NBS;
constexpr int AD = 512, CD = 512, NHEAD = 8, HD = 64, FF = 2816, NIN = 4608, CK = 31, BANDP = 512, SKV = 576;
constexpr int NROWT = NTOK / 256;
constexpr float EPS = 1e-6f, LOG2E = 1.4426950408889634f, QSCALE = 0.125f * 1.4426950408889634f;
constexpr int NWAVES = 8, NTHREADS = 512;

constexpr size_t MiB = 1u << 20;
constexpr size_t WS_BAR = 1 * MiB + 896 * 1024  , WS_MOD = 0, WS_CVEC = 1 * MiB, WS_WC = 2 * MiB, WS_WA = 3 * MiB, WS_WO = 4 * MiB, WS_WF1 = 6 * MiB, WS_WF2 = 17 * MiB;
constexpr size_t WS_WIN = 24 * MiB, WS_H = 32 * MiB, WS_WV = 100 * MiB, WS_U = 101 * MiB, WS_Q = 135 * MiB, WS_K = 169 * MiB, WS_VT = 219 * MiB, WS_SG = 269 * MiB, WS_SS = 405 * MiB;
constexpr size_t WS_Y = 32 * MiB, WS_O = 66 * MiB, WS_M1 = 101 * MiB, WS_MG = 169 * MiB, WS_A2 = 269 * MiB, WS_X1 = 337 * MiB, WS_ACT = 32 * MiB, WS_END = 410 * MiB;
static_assert(WS_H - WS_WIN == (size_t)4096 * 1024 * 2 && WS_WV - WS_H == (size_t)NTOK * 1024 * 2, "concatenated [Win | H | Wv] tile space");
constexpr size_t OUT_Y = 0, OUT_CSP = 35651584, OUT_KSP = 35682304, OUT_VSP = 36206592, OUT_CSS = 36730880, OUT_KNS = 37222400, OUT_VNS = 38270976, OUT_END = 39319552;
constexpr int LDS_BYTES = 147456;

__device__ __forceinline__ unsigned pk2(float lo, float hi) { typedef __bf16 b2 __attribute__((ext_vector_type(2))); f32x2 v = {lo, hi}; b2 b = __builtin_convertvector(v, b2); return __builtin_bit_cast(unsigned, b); }
__device__ __forceinline__ float bf_lo(unsigned w) { return __uint_as_float(w << 16); }
__device__ __forceinline__ float bf_hi(unsigned w) { return __uint_as_float(w & 0xffff0000u); }
__device__ __forceinline__ float sigm(float x) { return __builtin_amdgcn_rcpf(1.f + __builtin_amdgcn_exp2f(-LOG2E * x)); }
__device__ __forceinline__ u32x4 pack8(f32x4 a, f32x4 b) { u32x4 w; w.x = pk2(a[0], a[1]); w.y = pk2(a[2], a[3]); w.z = pk2(b[0], b[1]); w.w = pk2(b[2], b[3]); return w; }
__device__ __forceinline__ int bid_of(int row) { return row < NTP ? (row >> 14) : NBP + ((row - NTP) >> 6); }
__device__ __forceinline__ float wave_sum(float v) {
#pragma unroll
    for (int o = 1; o < 64; o <<= 1) v += __shfl_xor(v, o);
    return v;
}
__device__ __forceinline__ float quad_sum(float v) { v += __shfl_xor(v, 16); v += __shfl_xor(v, 32); return v; }

typedef const f32x4 (&AccRef)[2][2][4][2];

struct EpiIn {
    static constexpr bool PERM = true, AFTER_DRAIN = false;
    __device__ __forceinline__ bool keep_acc(const pg8::Unit&) const { return false; }
    bf16_t *U, *Q, *K, *VT, *SG; float* out; const float *qg, *kg;
    __device__ __forceinline__ void operator()(AccRef acc, const pg8::Unit& u, int wr, int wc, int fr, int fq) const {
        if (u.pm >= 16 + NROWT) {
            const int dg0 = (u.pm - 16 - NROWT) * 256 + wr * 64 + fr, tk0 = (u.pn - 16) * 256 + wc * 32 + fq * 8;
#pragma unroll
            for (int ai = 0; ai < 2; ++ai)
#pragma unroll
                for (int m = 0; m < 4; ++m) { const int dg = dg0 + ai * 128 + m * 16;
#pragma unroll
                    for (int bj = 0; bj < 2; ++bj) { const int tok = tk0 + bj * 128; const f32x4 v0 = acc[ai][bj][m][0], v1 = acc[ai][bj][m][1]; const u32x4 w = pack8(v0, v1);
                        int kidx; float* o;
                        if (tok < NTP) { const int b = tok >> 14, t = tok & (TP - 1); kidx = tok; o = (t >= TP - BANDP) ? out + OUT_VSP + ((size_t)(b * BANDP + t - (TP - BANDP)) * AD + dg) : nullptr; }
                        else { const int ts = tok - NTP; kidx = NTP + (ts >> 6) * SKV + BANDP + (ts & 63); o = out + OUT_VNS + ((size_t)ts * AD + dg); }
                        { const int kv0 = kidx & 63; bf16_t* vp = VT + ((size_t)((kidx >> 6) * NHEAD + (dg >> 6)) * 8 + ((dg >> 5) & 1) * 4 + (kv0 >> 4)) * 512 + (dg & 31) * 8 + ((kv0 >> 3) & 1) * 4;
                          *(u32x2*)vp = (u32x2){w.x, w.y}; *(u32x2*)(vp + 256) = (u32x2){w.z, w.w}; }
                        if (o) {
#pragma unroll
                            for (int j = 0; j < 4; ++j) { o[(size_t)j * AD] = v0[j]; o[(size_t)(j + 4) * AD] = v1[j]; } }
                    } }
            return;
        }
        const int row0 = (u.pm - 16) * 256 + wr * 64 + fr, pn = u.pn, cw = wc * 32 + fq * 8;
        if (pn < 4) {
#pragma unroll
            for (int ai = 0; ai < 2; ++ai)
#pragma unroll
                for (int m = 0; m < 4; ++m) { const int row = row0 + ai * 128 + m * 16; f32x4 r0, r1;
#pragma unroll
                    for (int e = 0; e < 4; ++e) { r0[e] = acc[ai][0][m][0][e] * sigm(acc[ai][1][m][0][e]); r1[e] = acc[ai][0][m][1][e] * sigm(acc[ai][1][m][1][e]); }
                    *(u32x4*)(U + (size_t)row * CD + pn * 128 + cw) = pack8(r0, r1); }
        } else if (pn < 8) {
            const bool isk = pn >= 6; const int head = ((pn - 4) & 1) * 4 + wc; const float* g = isk ? kg : qg; const float sc = isk ? 1.f : QSCALE;
            f32x4 gv[2][2];
#pragma unroll
            for (int bj = 0; bj < 2; ++bj)
#pragma unroll
                for (int n = 0; n < 2; ++n) gv[bj][n] = *(const f32x4*)(g + bj * 32 + fq * 8 + n * 4) * sc;
#pragma unroll
            for (int ai = 0; ai < 2; ++ai)
#pragma unroll
                for (int m = 0; m < 4; ++m) { const int row = row0 + ai * 128 + m * 16; float ss = 0.f;
#pragma unroll
                    for (int bj = 0; bj < 2; ++bj)
#pragma unroll
                        for (int n = 0; n < 2; ++n) { const f32x4 v = acc[ai][bj][m][n]; ss += (v[0] * v[0] + v[1] * v[1]) + (v[2] * v[2] + v[3] * v[3]); }
                    ss = quad_sum(ss); const float rstd = rsqrtf(ss * (1.f / 64.f) + EPS);
                    f32x4 o[2][2];
#pragma unroll
                    for (int bj = 0; bj < 2; ++bj)
#pragma unroll
                        for (int n = 0; n < 2; ++n) o[bj][n] = acc[ai][bj][m][n] * rstd * gv[bj][n];
                    const int hc = head * HD + fq * 8;
                    if (!isk) {
#pragma unroll
                        for (int bj = 0; bj < 2; ++bj) *(u32x4*)(Q + (size_t)row * AD + hc + bj * 32) = pack8(o[bj][0], o[bj][1]);
                    } else {
                        size_t krow; float* fo;
                        if (row < NTP) { krow = (size_t)row; const int b = row >> 14, t = row & (TP - 1); fo = (t >= TP - BANDP) ? out + OUT_KSP + (size_t)(b * BANDP + t - (TP - BANDP)) * AD : nullptr; }
                        else { const int ts = row - NTP; krow = (size_t)NTP + (size_t)(ts >> 6) * SKV + BANDP + (ts & 63); fo = out + OUT_KNS + (size_t)ts * AD; }
#pragma unroll
                        for (int bj = 0; bj < 2; ++bj) { *(u32x4*)(K + ((size_t)((krow >> 6) * NHEAD + head) * 8 + (((int)krow >> 5) & 1) * 4 + 2 * bj + (fq >> 1)) * 512 + ((fq & 1) * 32 + ((int)krow & 31)) * 8) = pack8(o[bj][0], o[bj][1]);
                            if (fo) { *(f32x4*)(fo + hc + bj * 32) = o[bj][0]; *(f32x4*)(fo + hc + bj * 32 + 4) = o[bj][1]; } }
                    } }
        } else {
#pragma unroll
            for (int ai = 0; ai < 2; ++ai)
#pragma unroll
                for (int m = 0; m < 4; ++m) { const int row = row0 + ai * 128 + m * 16; f32x4 r[2], t2[2];
#pragma unroll
                    for (int n = 0; n < 2; ++n)
#pragma unroll
                        for (int e = 0; e < 4; ++e) { const float ec = __builtin_amdgcn_exp2f(-LOG2E * acc[ai][0][m][n][e]), ea = fminf(__builtin_amdgcn_exp2f(-LOG2E * acc[ai][1][m][n][e]), 1e30f);
                            r[n][e] = (1.f + ea) * __builtin_amdgcn_rcpf(1.f + ec); t2[n][e] = __builtin_amdgcn_rcpf(1.f + ea); }
                    *(u32x4*)(SG + (size_t)row * 2048 + (pn - 8) * 128 + cw) = pack8(r[0], r[1]);
                    *(u32x4*)(SG + (size_t)row * 2048 + 1024 + (pn - 8) * 128 + cw) = pack8(t2[0], t2[1]); }
        }
    }
};
struct OrderIn {
    pg8::StaticOrder so; int G, c;
    __device__ __forceinline__ void init(int G_, int c_) { so.init(NTOK, 4096, G_, c_); G = G_; c = c_; }
    __device__ __forceinline__ bool next(int i, pg8::Unit& u) const {
        if (so.next(i, u)) { u.pm += 16; return true; }
        const int Lv = i * G + c - NROWT * 16; if (Lv >= 2 * NROWT) return false;
        u.pm = 16 + NROWT + (Lv & 1); u.pn = 16 + (Lv >> 1); u.sub = -1; return true;
    }
    __device__ __forceinline__ void a_ready(const pg8::Unit&) const {}
    __device__ __forceinline__ void done(const pg8::Unit&) const {}
};
template <int SECOND> struct EpiMerge {
    static constexpr bool PERM = true, AFTER_DRAIN = false;
    __device__ __forceinline__ bool keep_acc(const pg8::Unit&) const { return false; }
    const bf16_t* SG; bf16_t* M1; bf16_t* MG;
    __device__ __forceinline__ void operator()(AccRef acc, const pg8::Unit& u, int wr, int wc, int fr, int fq) const {
        const bool qt = u.sub >= 0; const int roff = u.sub >= 2 ? 128 : 0, coff = (qt && (u.sub & 1)) ? 128 : 0;
        const int row0 = u.pm * 256 + roff + wr * 64 + fr, col0 = u.pn * 256 + coff + wc * 32 + fq * 8;
#pragma unroll
        for (int ai = 0; ai < 2; ++ai) { if (qt && ai) break;
#pragma unroll
            for (int m = 0; m < 4; ++m) { const int row = row0 + ai * 128 + m * 16;
#pragma unroll
                for (int bj = 0; bj < 2; ++bj) { if (qt && bj) break; const int col = col0 + bj * 128;
                    const u32x4 gw = *(const u32x4*)(SG + (size_t)row * 2048 + SECOND * 1024 + col);
                    f32x4 r0 = acc[ai][bj][m][0], r1 = acc[ai][bj][m][1];
                    r0[0] *= bf_lo(gw.x); r0[1] *= bf_hi(gw.x); r0[2] *= bf_lo(gw.y); r0[3] *= bf_hi(gw.y); r1[0] *= bf_lo(gw.z); r1[1] *= bf_hi(gw.z); r1[2] *= bf_lo(gw.w); r1[3] *= bf_hi(gw.w);
                    if (SECOND) { const u32x4 pw = *(const u32x4*)(M1 + (size_t)row * DM + col);
                        r0[0] += bf_lo(pw.x); r0[1] += bf_hi(pw.x); r0[2] += bf_lo(pw.y); r0[3] += bf_hi(pw.y); r1[0] += bf_lo(pw.z); r1[1] += bf_hi(pw.z); r1[2] += bf_lo(pw.w); r1[3] += bf_hi(pw.w);
                        *(u32x4*)(MG + (size_t)row * DM + col) = pack8(r0, r1);
                    } else *(u32x4*)(M1 + (size_t)row * DM + col) = pack8(r0, r1); } } }
    }
};
struct EpiMergeFused {
    static constexpr bool PERM = true, AFTER_DRAIN = false;
    const bf16_t* SG; bf16_t* MG;
    __device__ __forceinline__ bool keep_acc(const pg8::Unit& u) const { return u.pm < NROWT; }
    __device__ __forceinline__ void operator()(f32x4 (&acc)[2][2][4][2], const pg8::Unit& u, int wr, int wc, int fr, int fq) const {
        const bool second = u.pm >= NROWT; const int pm = second ? u.pm - NROWT : u.pm, pn = second ? u.pn - 4 : u.pn;
        const bool qt = u.sub >= 0; const int roff = u.sub >= 2 ? 128 : 0, coff = (qt && (u.sub & 1)) ? 128 : 0;
        const int row0 = pm * 256 + roff + wr * 64 + fr, col0 = pn * 256 + coff + wc * 32 + fq * 8;
        u32x4 gw[2][4][2];
        const bf16_t* gp = SG + (size_t)row0 * 2048 + (second ? 1024 : 0) + col0;
#pragma unroll
        for (int ai = 0; ai < 2; ++ai) { if (qt && ai) break;
#pragma unroll
            for (int m = 0; m < 4; ++m)
#pragma unroll
                for (int bj = 0; bj < 2; ++bj) { if (qt && bj) break; gw[ai][m][bj] = *(const u32x4*)(gp + (size_t)(ai * 128 + m * 16) * 2048 + bj * 128); } }
#pragma unroll
        for (int ai = 0; ai < 2; ++ai) { if (qt && ai) break;
#pragma unroll
            for (int m = 0; m < 4; ++m) { const int row = row0 + ai * 128 + m * 16;
#pragma unroll
                for (int bj = 0; bj < 2; ++bj) { if (qt && bj) break; const int col = col0 + bj * 128; const u32x4 g = gw[ai][m][bj];
                    const f32x4 ga = {bf_lo(g.x), bf_hi(g.x), bf_lo(g.y), bf_hi(g.y)}, gb = {bf_lo(g.z), bf_hi(g.z), bf_lo(g.w), bf_hi(g.w)};
                    if (!second) { acc[ai][bj][m][0] *= ga; acc[ai][bj][m][1] *= gb; }
                    else *(u32x4*)(MG + (size_t)row * DM + col) = pack8(acc[ai][bj][m][0] * ga, acc[ai][bj][m][1] * gb); } } }
    }
};
struct PairOrder {
    pg8::TailOrder t;
    __device__ __forceinline__ void init(int M, int N, int G_, int c_) { t.init(M, N, G_, c_); }
    __device__ __forceinline__ bool next(int i, pg8::Unit& u) const { if (!t.next(i >> 1, u)) return false; if (i & 1) { u.pm += NROWT; u.pn += 4; } return true; }
    __device__ __forceinline__ void a_ready(const pg8::Unit&) const {}
    __device__ __forceinline__ void done(const pg8::Unit&) const {}
};
struct EpiX1 {
    static constexpr bool PERM = true, AFTER_DRAIN = false;
    __device__ __forceinline__ bool keep_acc(const pg8::Unit&) const { return false; }
    const float *xp, *xs, *mod, *g2; bf16_t* X1; bf16_t* A2; float* SS;
    __device__ __forceinline__ void operator()(AccRef acc, const pg8::Unit& u, int wr, int wc, int fr, int fq) const {
        const bool qt = u.sub >= 0; const int roff = u.sub >= 2 ? 128 : 0, cq = (qt && (u.sub & 1)) ? 1 : 0;
        const int col0 = u.pn * 256 + cq * 128 + wc * 32 + fq * 8;
#pragma unroll
        for (int ai = 0; ai < 2; ++ai) { if (qt && ai) break; const int rowa = u.pm * 256 + roff + ai * 128 + wr * 64; const int b = bid_of(rowa); const float* mb = mod + (size_t)b * 6144;
            f32x4 gt[2][2], gs[2][2];
#pragma unroll
            for (int bj = 0; bj < 2; ++bj)
#pragma unroll
                for (int n = 0; n < 2; ++n) { const int col = col0 + bj * 128 + n * 4; if (qt && bj) { gt[bj][n] = gt[0][n]; gs[bj][n] = gs[0][n]; } else { gt[bj][n] = *(const f32x4*)(mb + 2048 + col); gs[bj][n] = *(const f32x4*)(g2 + col) * (*(const f32x4*)(mb + 4096 + col) + 1.f); } }
#pragma unroll
            for (int m = 0; m < 4; ++m) { const int row = rowa + m * 16 + fr; const float* xr = row < NTP ? xp + (size_t)row * DM : xs + (size_t)(row - NTP) * DM;
#pragma unroll
                for (int bj = 0; bj < 2; ++bj) { if (qt && bj) break; f32x4 x1[2]; float ss = 0.f;
#pragma unroll
                    for (int n = 0; n < 2; ++n) { const int col = col0 + bj * 128 + n * 4; x1[n] = *(const f32x4*)(xr + col) + gt[bj][n] * acc[ai][bj][m][n];
                        ss += (x1[n][0] * x1[n][0] + x1[n][1] * x1[n][1]) + (x1[n][2] * x1[n][2] + x1[n][3] * x1[n][3]); }
                    *(u32x4*)(X1 + (size_t)row * DM + col0 + bj * 128) = pack8(x1[0], x1[1]);
                    *(u32x4*)(A2 + (size_t)row * DM + col0 + bj * 128) = pack8(x1[0] * gs[bj][0], x1[1] * gs[bj][1]);
                    ss = quad_sum(ss); if (fq == 0) SS[(size_t)row * 32 + u.pn * 8 + (cq + bj) * 4 + wc] = ss; } } }
    }
};
struct EpiFfn {
    static constexpr bool PERM = true, AFTER_DRAIN = false;
    __device__ __forceinline__ bool keep_acc(const pg8::Unit&) const { return false; }
    const float *SS, *cvec; bf16_t* ACT;
    __device__ __forceinline__ void operator()(AccRef acc, const pg8::Unit& u, int wr, int wc, int fr, int fq) const {
        const int cl = u.pn * 128 + wc * 32 + fq * 8, rowa0 = u.pm * 256 + wr * 64, b0 = bid_of(rowa0), b1 = bid_of(rowa0 + 128);
        f32x4 pt[2][4], pu[2][4];
#pragma unroll
        for (int ai = 0; ai < 2; ++ai)
#pragma unroll
            for (int m = 0; m < 4; ++m) { const float* sp = SS + (size_t)(rowa0 + ai * 128 + m * 16 + fr) * 32 + fq * 8; pt[ai][m] = *(const f32x4*)sp; pu[ai][m] = *(const f32x4*)(sp + 4); }
        const float* cb = cvec + (size_t)b0 * (2 * FF) + cl;
        f32x4 cg0 = *(const f32x4*)(cb), cg1 = *(const f32x4*)(cb + 4), cu0 = *(const f32x4*)(cb + FF), cu1 = *(const f32x4*)(cb + FF + 4);
#pragma unroll
        for (int ai = 0; ai < 2; ++ai) {
            if (ai == 1 && b1 != b0) { const float* c1 = cvec + (size_t)b1 * (2 * FF) + cl; cg0 = *(const f32x4*)(c1); cg1 = *(const f32x4*)(c1 + 4); cu0 = *(const f32x4*)(c1 + FF); cu1 = *(const f32x4*)(c1 + FF + 4); }
#pragma unroll
            for (int m = 0; m < 4; ++m) { const int row = rowa0 + ai * 128 + m * 16 + fr; const f32x4 a4 = pt[ai][m], b4 = pu[ai][m];
                const float rstd = rsqrtf(quad_sum(((a4[0] + a4[1]) + (a4[2] + a4[3])) + ((b4[0] + b4[1]) + (b4[2] + b4[3]))) * (1.f / DM) + EPS);
                const f32x4 g0 = acc[ai][0][m][0] * rstd + cg0, g1 = acc[ai][0][m][1] * rstd + cg1, u0 = acc[ai][1][m][0] * rstd + cu0, u1 = acc[ai][1][m][1] * rstd + cu1; f32x4 r0, r1;
#pragma unroll
                for (int e = 0; e < 4; ++e) { r0[e] = g0[e] * sigm(g0[e]) * u0[e]; r1[e] = g1[e] * sigm(g1[e]) * u1[e]; }
                *(u32x4*)(ACT + (size_t)row * FF + cl) = pack8(r0, r1); } }
    }
};
struct EpiOut {
    static constexpr bool PERM = true, AFTER_DRAIN = false;
    __device__ __forceinline__ bool keep_acc(const pg8::Unit&) const { return false; }
    const float* mod; const bf16_t* X1; float* Y;
    __device__ __forceinline__ void operator()(AccRef acc, const pg8::Unit& u, int wr, int wc, int fr, int fq) const {
        const bool qt = u.sub >= 0; const int roff = u.sub >= 2 ? 128 : 0, coff = (qt && (u.sub & 1)) ? 128 : 0;
        const int col0 = u.pn * 256 + coff + wc * 32 + fq * 8, rowa0 = u.pm * 256 + roff + wr * 64, b0 = bid_of(rowa0), b1 = bid_of(rowa0 + 128);
        u32x4 xw[2][4][2];
#pragma unroll
        for (int ai = 0; ai < 2; ++ai) { if (qt && ai) break;
#pragma unroll
            for (int m = 0; m < 4; ++m)
#pragma unroll
                for (int bj = 0; bj < 2; ++bj) { if (qt && bj) break; xw[ai][m][bj] = *(const u32x4*)(X1 + (size_t)(rowa0 + ai * 128 + m * 16 + fr) * DM + col0 + bj * 128); } }
        f32x4 gt[2][2];
#pragma unroll
        for (int bj = 0; bj < 2; ++bj) { if (qt && bj) break; const float* mb = mod + (size_t)b0 * 6144 + 5120 + col0 + bj * 128; gt[bj][0] = *(const f32x4*)mb; gt[bj][1] = *(const f32x4*)(mb + 4); }
#pragma unroll
        for (int ai = 0; ai < 2; ++ai) { if (qt && ai) break;
            if (ai == 1 && b1 != b0) {
#pragma unroll
                for (int bj = 0; bj < 2; ++bj) { const float* mb = mod + (size_t)b1 * 6144 + 5120 + col0 + bj * 128; gt[bj][0] = *(const f32x4*)mb; gt[bj][1] = *(const f32x4*)(mb + 4); } }
#pragma unroll
            for (int m = 0; m < 4; ++m) { const size_t ro = (size_t)(rowa0 + ai * 128 + m * 16 + fr) * DM;
#pragma unroll
                for (int bj = 0; bj < 2; ++bj) { if (qt && bj) break; const int col = col0 + bj * 128; const u32x4 w = xw[ai][m][bj];
                    *(f32x4*)(Y + ro + col) = (f32x4){bf_lo(w.x), bf_hi(w.x), bf_lo(w.y), bf_hi(w.y)} + gt[bj][0] * acc[ai][bj][m][0];
                    *(f32x4*)(Y + ro + col + 4) = (f32x4){bf_lo(w.z), bf_hi(w.z), bf_lo(w.w), bf_hi(w.w)} + gt[bj][1] * acc[ai][bj][m][1]; } } }
    }
};

__device__ __forceinline__ void tr_item(const float* W, int N, int k0, int n0, bf16_t* WT, size_t ldo, int drowA, int drowB, LAS float* scr, int lane) {
    f32x4 v[16];
    const float* wp = W + (size_t)(k0 + (lane >> 4)) * N + n0 + (lane & 15) * 4;
#pragma unroll
    for (int i = 0; i < 16; ++i) v[i] = *(const f32x4*)(wp + (size_t)(4 * i) * N);
#pragma unroll
    for (int i = 0; i < 16; ++i) { LAS float* d = scr + (4 * i + (lane >> 4)) * 65 + (lane & 15) * 4; d[0] = v[i][0]; d[1] = v[i][1]; d[2] = v[i][2]; d[3] = v[i][3]; }
    asm volatile("s_waitcnt lgkmcnt(0)" ::: "memory");
    const int c = lane & 7;
#pragma unroll
    for (int j = 0; j < 8; ++j) { const int n = (lane >> 3) + 8 * j; const LAS float* sp = scr + (8 * c) * 65 + n;
        u32x4 o; o.x = pk2(sp[0 * 65], sp[1 * 65]); o.y = pk2(sp[2 * 65], sp[3 * 65]); o.z = pk2(sp[4 * 65], sp[5 * 65]); o.w = pk2(sp[6 * 65], sp[7 * 65]);
        const int drow = (j < 4 ? drowA + n : drowB + n - 32);
        *(u32x4*)(WT + (size_t)drow * ldo + k0 + 8 * c) = o; }
    asm volatile("s_waitcnt lgkmcnt(0)" ::: "memory");
}
__device__ __forceinline__ int win_dest(int n0) {
    if (n0 < 512) return 256 * (n0 >> 7) + (n0 & 127);
    if (n0 < 1024) { const int n = n0 - 512; return 256 * (n >> 7) + 128 + (n & 127); }
    if (n0 < 2048) { const int base = n0 < 1536 ? 1024 : 1536, n = n0 - base; return base + 256 * (n >> 8) + 128 * ((n & 63) >> 5) + 32 * ((n & 255) >> 6); }
    if (n0 < 2560) return -(n0 - 2048) - 1;
    if (n0 < 3584) { const int n = n0 - 2560; return 2048 + 256 * (n >> 7) + (n & 127); }
    { const int n = n0 - 3584; return 2048 + 256 * (n >> 7) + 128 + (n & 127); }
}
__device__ __forceinline__ int ffn_dest(int n0) { if (n0 < FF) return 256 * (n0 >> 7) + (n0 & 127); const int n = n0 - FF; return 256 * (n >> 7) + 128 + (n & 127); }

template <int MODE> __device__ __forceinline__ void gemv34(LAS unsigned char* lds, int task, const float* W, int N, const float* bias, float* out, const float* cp, const float* cs, const float* mod, int tid, int lane, int wave) {
    LAS float* S = (LAS float*)lds;
    { f32x2 sv[NB];
#pragma unroll
      for (int b = 0; b < NB; ++b) sv[b] = MODE == 0 ? *(const f32x2*)((b < NBP ? cp + b * DM : cs + (b - NBP) * DM) + 2 * tid) : *(const f32x2*)(mod + (size_t)b * 6144 + 3072 + 2 * tid);
#pragma unroll
      for (int b = 0; b < NB; ++b) { f32x2 v = sv[b]; if (MODE == 0) { v[0] *= sigm(v[0]); v[1] *= sigm(v[1]); } *(LAS f32x2*)(S + b * DM + 2 * tid) = v; } }
    __syncthreads();
    float acc[NB];
#pragma unroll
    for (int b = 0; b < NB; ++b) acc[b] = 0.f;
    const int kbase = wave * 128 + (lane >> 5) * 64;
    const float* wp = W + (size_t)kbase * N + task * 32 + (lane & 31);
    const LAS float* sp = S + kbase;
#pragma unroll 2
    for (int k4 = 0; k4 < 16; ++k4) { const float w0 = wp[0], w1 = wp[N], w2 = wp[2 * (size_t)N], w3 = wp[3 * (size_t)N]; wp += 4 * (size_t)N;
#pragma unroll
        for (int b = 0; b < NB; ++b) { const f32x4 s4 = *(const LAS f32x4*)(sp + b * DM + 4 * k4); acc[b] += (s4[0] * w0 + s4[1] * w1) + (s4[2] * w2 + s4[3] * w3); } }
    __syncthreads();
#pragma unroll
    for (int b = 0; b < NB; ++b) S[(wave * NB + b) * 64 + lane] = acc[b];
    __syncthreads();
    for (int idx = tid; idx < NB * 32; idx += NTHREADS) { const int b = idx >> 5, c = idx & 31; float s = 0.f;
#pragma unroll
        for (int w = 0; w < NWAVES; ++w) s += S[(w * NB + b) * 64 + c] + S[(w * NB + b) * 64 + 32 + c];
        out[(size_t)b * N + task * 32 + c] = s + (bias ? bias[task * 32 + c] : 0.f); }
    __syncthreads();
}

__device__ __forceinline__ void conv_unit(int cu, LAS unsigned char* lds, const bf16_t* U, const float* cache_conv, const float* w_dw, const float* b_dw, const float* ln_g, const float* ln_b, bf16_t* Y, float* out, int tid, int lane, int wave) {
    int tokbase, t0, T, seq; const bool samp = cu >= 1024;
    if (!samp) { seq = cu >> 9; t0 = (cu & 511) * 32; tokbase = seq * TP; T = TP; } else { const int c2 = cu - 1024; seq = c2 >> 1; t0 = (c2 & 1) * 32; tokbase = NTP + seq * TS; T = TS; }
    LAS unsigned* inb = (LAS unsigned*)lds;
    LAS float* yb = (LAS float*)(lds + 63488);
    for (int r = wave; r < 62; r += NWAVES) { const int t = t0 - 30 + r;
        if (t >= 0) __builtin_amdgcn_global_load_lds((const unsigned*)(U + (size_t)(tokbase + t) * CD + lane * 8), (LAS unsigned*)(inb + r * 256), 16, 0, 0);
        else { u32x4 v = {0u, 0u, 0u, 0u};
            if (samp) { const float* cc = cache_conv + ((size_t)seq * 30 + 30 + t) * CD + lane * 8; v = pack8(*(const f32x4*)cc, *(const f32x4*)(cc + 4)); }
            *(LAS u32x4*)(inb + r * 256 + lane * 4) = v; } }
    asm volatile("s_waitcnt vmcnt(0)" ::: "memory");
    __syncthreads();
    if (t0 == T - 32) {
        float* o = out + (samp ? OUT_CSS : OUT_CSP) + (size_t)seq * 30 * CD;
        for (int idx = tid; idx < 30 * 256; idx += NTHREADS) { const int r = idx >> 8, c2 = idx & 255; const unsigned v = inb[(32 + r) * 256 + c2]; *(f32x2*)(o + (size_t)r * CD + 2 * c2) = (f32x2){bf_lo(v), bf_hi(v)}; }
    }
    { const int cp = tid & 255, half = tid >> 8;
      f32x2 w[CK];
#pragma unroll
      for (int j = 0; j < CK; ++j) w[j] = *(const f32x2*)(w_dw + j * CD + 2 * cp);
      const f32x2 bb = *(const f32x2*)(b_dw + 2 * cp);
      f32x2 acc[16];
#pragma unroll
      for (int o = 0; o < 16; ++o) acc[o] = bb;
      const LAS unsigned* ip = inb + (16 * half) * 256 + cp; unsigned vc = ip[0], vn = 0u;
#pragma unroll
      for (int i = 0; i < 46; ++i) { if (i + 1 < 46) vn = ip[(i + 1) * 256]; const f32x2 x = {bf_lo(vc), bf_hi(vc)};
#pragma unroll
          for (int o = 0; o < 16; ++o) { const int j = i - o; if (j >= 0 && j < CK) acc[o] += w[j] * x; }
          __builtin_amdgcn_sched_barrier(0); vc = vn; }
#pragma unroll
      for (int o = 0; o < 16; ++o) *(LAS f32x2*)(yb + (16 * half + o) * CD + 2 * cp) = acc[o];
    }
    __syncthreads();
    const f32x4 g0 = *(const f32x4*)(ln_g + lane * 8), g1 = *(const f32x4*)(ln_g + lane * 8 + 4), b0 = *(const f32x4*)(ln_b + lane * 8), b1 = *(const f32x4*)(ln_b + lane * 8 + 4);
#pragma unroll
    for (int rr = 0; rr < 4; ++rr) { const int row = wave * 4 + rr;
        f32x4 v0 = *(const LAS f32x4*)(yb + row * CD + lane * 8), v1 = *(const LAS f32x4*)(yb + row * CD + lane * 8 + 4);
        const float mu = wave_sum((v0[0] + v0[1]) + (v0[2] + v0[3]) + (v1[0] + v1[1]) + (v1[2] + v1[3])) * (1.f / CD);
        v0 = v0 - mu; v1 = v1 - mu;
        const float var = wave_sum((v0[0] * v0[0] + v0[1] * v0[1]) + (v0[2] * v0[2] + v0[3] * v0[3]) + (v1[0] * v1[0] + v1[1] * v1[1]) + (v1[2] * v1[2] + v1[3] * v1[3])) * (1.f / CD);
        const float rstd = rsqrtf(var + EPS);
        v0 = v0 * rstd * g0 + b0; v1 = v1 * rstd * g1 + b1;
#pragma unroll
        for (int e = 0; e < 4; ++e) { v0[e] *= sigm(v0[e]); v1[e] *= sigm(v1[e]); }
        *(u32x4*)(Y + (size_t)(tokbase + t0 + row) * CD + lane * 8) = pack8(v0, v1); }
    __syncthreads();
}

__device__ __forceinline__ int crow(int r, int hi) { return (r & 3) + 8 * (r >> 2) + 4 * hi; }
__device__ __forceinline__ float max3f(float a, float b, float c) { float r; asm("v_max3_f32 %0, %1, %2, %3" : "=v"(r) : "v"(a), "v"(b), "v"(c)); return r; }
__device__ __forceinline__ float max2f(float a, float b) { float r; asm("v_max_f32_e32 %0, %1, %2" : "=v"(r) : "v"(a), "v"(b)); return r; }
#define MFMA32(a, b, c) __builtin_amdgcn_mfma_f32_32x32x16_bf16((a), (b), (c), 0, 0, 0)
__device__ __forceinline__ void attn_unit(int wu, const bf16_t* Q, const bf16_t* K, const bf16_t* VT, bf16_t* O, const LAS float* rb, int lane) {
    const int r32 = lane & 31, hi = lane >> 5;
    int h, qtok0, jstart, cb, half;
    if (wu < 8192) { half = wu & 1; const int n = (wu >> 1) & 255; h = (wu >> 9) & 7; const int b = wu >> 12; qtok0 = b * TP + 64 * n + 32 * half; cb = b * 256 + n - 8; jstart = n < 8 ? 8 - n : 0; }
    else { const int w2 = wu - 8192; half = w2 & 1; h = (w2 >> 1) & 7; const int sb = w2 >> 4; qtok0 = NTP + sb * TS + 32 * half; cb = 512 + sb * 9; jstart = 0; }
    const bf16_t* Kt = K + ((size_t)(cb * NHEAD + h)) * 4096 + lane * 8; const bf16_t* Vt = VT + ((size_t)(cb * NHEAD + h)) * 4096 + lane * 8;
    bf16x8 qf[4];
    { const bf16_t* qp = Q + (size_t)(qtok0 + r32) * AD + h * HD + 8 * hi;
#pragma unroll
      for (int d0 = 0; d0 < 4; ++d0) qf[d0] = *(const bf16x8*)(qp + 16 * d0); }
    const int qi = 32 * half + r32; const LAS float* rbh = rb + h * 257;
    float mref = 0.f, l = 0.f; f32x16 o0 = {}, o1 = {}, negm = {};
    bf16x8 kf[2][8];
#pragma unroll
    for (int j = 0; j < 9; ++j) {
        if (j == jstart) {
#pragma unroll
            for (int i = 0; i < 8; ++i) kf[j & 1][i] = *(const bf16x8*)(Kt + (size_t)j * 32768 + i * 512);
        }
        if (j >= jstart) {
            const bool first = (j == jstart);
            bf16x8 vf[8];
#pragma unroll
            for (int i = 0; i < 8; ++i) vf[i] = *(const bf16x8*)(Vt + (size_t)j * 32768 + i * 512);
            if (j < 8) {
#pragma unroll
                for (int i = 0; i < 8; ++i) kf[(j + 1) & 1][i] = *(const bf16x8*)(Kt + (size_t)(j + 1) * 32768 + i * 512);
            }
            f32x16 p0, p1;
            p0 = MFMA32(kf[j & 1][0], qf[0], negm); p1 = MFMA32(kf[j & 1][4], qf[0], negm);
#pragma unroll
            for (int d0 = 1; d0 < 4; ++d0) { p0 = MFMA32(kf[j & 1][d0], qf[d0], p0); p1 = MFMA32(kf[j & 1][4 + d0], qf[d0], p1); }
            asm volatile("s_nop 15\n\ts_nop 7" : "+v"(p0), "+v"(p1));
            const int c = 8 - j;
            if (c < 3) { const int base = 64 * c + qi + 128;
#pragma unroll
                for (int i = 0; i < 16; ++i) { const int kv = crow(i, hi); const int i0 = base - kv, i1 = base - kv - 32; p0[i] += rbh[i0 > 256 ? 256 : i0]; p1[i] += rbh[i1 > 256 ? 256 : i1]; }
            }
            float ma = max3f(p0[0], p0[1], p1[0]), mb = max3f(p0[2], p0[3], p1[1]); ma = max3f(ma, p1[2], p1[3]);
#pragma unroll
            for (int i = 4; i < 16; i += 4) { ma = max3f(ma, p0[i], p0[i + 1]); mb = max3f(mb, p0[i + 2], p0[i + 3]); ma = max3f(ma, p1[i], p1[i + 1]); mb = max3f(mb, p1[i + 2], p1[i + 3]); }
            float mt = max2f(ma, mb); mt = max2f(mt, __shfl_xor(mt, 32));
            if (first || __any(mt > 8.f)) { const float dl = first ? mt : fmaxf(mt, 0.f), f = first ? 1.f : __builtin_amdgcn_exp2f(-dl); mref += dl; l *= f;
#pragma unroll
                for (int i = 0; i < 16; ++i) { o0[i] *= f; o1[i] *= f; p0[i] -= dl; p1[i] -= dl; negm[i] = -mref; } }
            float ls = 0.f;
#pragma unroll
            for (int i = 0; i < 16; ++i) { p0[i] = __builtin_amdgcn_exp2f(p0[i]); p1[i] = __builtin_amdgcn_exp2f(p1[i]); ls += p0[i] + p1[i]; }
            l += ls;
            u32x4 pw[4];
#pragma unroll
            for (int s2 = 0; s2 < 2; ++s2) { pw[s2] = (u32x4){pk2(p0[8 * s2], p0[8 * s2 + 1]), pk2(p0[8 * s2 + 2], p0[8 * s2 + 3]), pk2(p0[8 * s2 + 4], p0[8 * s2 + 5]), pk2(p0[8 * s2 + 6], p0[8 * s2 + 7])};
                                             pw[2 + s2] = (u32x4){pk2(p1[8 * s2], p1[8 * s2 + 1]), pk2(p1[8 * s2 + 2], p1[8 * s2 + 3]), pk2(p1[8 * s2 + 4], p1[8 * s2 + 5]), pk2(p1[8 * s2 + 6], p1[8 * s2 + 7])}; }
#pragma unroll
            for (int s2 = 0; s2 < 4; ++s2) { const bf16x8 pa = __builtin_bit_cast(bf16x8, pw[s2]); o0 = MFMA32(vf[s2], pa, o0); o1 = MFMA32(vf[4 + s2], pa, o1); }
        }
    }
    l += __shfl_xor(l, 32); const float inv = 1.f / l;
    bf16_t* op = O + (size_t)(qtok0 + r32) * AD + h * HD + 4 * hi;
#pragma unroll
    for (int g = 0; g < 4; ++g) {
        *(u32x2*)(op + 8 * g) = (u32x2){pk2(o0[4 * g] * inv, o0[4 * g + 1] * inv), pk2(o0[4 * g + 2] * inv, o0[4 * g + 3] * inv)};
        *(u32x2*)(op + 32 + 8 * g) = (u32x2){pk2(o1[4 * g] * inv, o1[4 * g + 1] * inv), pk2(o1[4 * g + 2] * inv, o1[4 * g + 3] * inv)}; }
}

#define XB_TMO      128
#define XB_XCNT(j)  (256  + 64 * (j))
#define XB_XSUB(j)  (1280 + 64 * (j))
#define XB_XGEN(j)  (2304 + 64 * (j))
#define XB_TOP      3328
#define XB_TOPGEN   3392
#define XCD_BAR_WORDS 3456
#define XB_SPIN_CAP (1u << 18)

__device__ __forceinline__ unsigned xb_ld(unsigned* p)              { return __hip_atomic_load(p, __ATOMIC_RELAXED, __HIP_MEMORY_SCOPE_AGENT); }
__device__ __forceinline__ unsigned xb_add(unsigned* p, unsigned v) { return __hip_atomic_fetch_add(p, v, __ATOMIC_RELAXED, __HIP_MEMORY_SCOPE_AGENT); }
__device__ __forceinline__ unsigned xb_xcc_id() { return (unsigned)__builtin_amdgcn_s_getreg((3 << 11) | 20) & 0xFu; }
#define XB_SPIN(cond, bar) do { unsigned _sp = 0; while (cond) { __builtin_amdgcn_s_sleep(1); \
    if ((++_sp & 255u) == 0u) { if (xb_ld(&(bar)[XB_TMO])) break; if (_sp > XB_SPIN_CAP) { atomicAdd(&(bar)[XB_TMO], 1u); break; } } } } while (0)

struct XcdBarrier {
    unsigned* bar; unsigned x;
    volatile LAS unsigned* st;
};

__device__ __forceinline__ XcdBarrier xcd_barrier_post(unsigned* bar, volatile LAS unsigned* st) {
    XcdBarrier b; b.bar = bar; b.x = xb_xcc_id(); b.st = st;
    if (threadIdx.x == 0) (void)xb_add(&bar[XB_XCNT(b.x)], 1u);
    return b;
}
__device__ __forceinline__ void xcd_barrier_complete(unsigned* bar, unsigned x, unsigned& nloc, unsigned& nx) {
    const unsigned G = gridDim.x * gridDim.y * gridDim.z;
    unsigned sum, cnt, mine, sp = 0u;
    for (;;) {
        sum = 0u; cnt = 0u; mine = 0u;
#pragma unroll
        for (unsigned j = 0; j < 16; ++j) { const unsigned c = xb_ld(&bar[XB_XCNT(j)]); sum += c; cnt += (c > 0u) ? 1u : 0u; mine = (j == x) ? c : mine; }
        if (sum == G) break;
        __builtin_amdgcn_s_sleep(1);
        if ((++sp & 255u) == 0u) { if (xb_ld(&bar[XB_TMO])) break; if (sp > XB_SPIN_CAP) { atomicAdd(&bar[XB_TMO], 1u); break; } }
    }
    nloc = mine > 0u ? mine : 1u; nx = cnt > 0u ? cnt : 1u;
}

__device__ __forceinline__ void xcd_barrier(const XcdBarrier& b) {
    asm volatile("s_waitcnt vmcnt(0)" ::: "memory");
    __syncthreads();
    if (threadIdx.x == 0) {
        unsigned* bar = b.bar;
        __builtin_amdgcn_s_waitcnt(0);
        unsigned nloc = b.st[0], nx = b.st[1];
        if (nloc == 0u) { xcd_barrier_complete(bar, b.x, nloc, nx); b.st[0] = nloc; b.st[1] = nx; }
        const unsigned old = xb_add(&bar[XB_XSUB(b.x)], 1u);
        const unsigned gen = old / nloc;
        if (old + 1u == (gen + 1u) * nloc) {
            __builtin_amdgcn_fence(__ATOMIC_RELEASE, "agent");
            asm volatile("s_waitcnt vmcnt(0)" ::: "memory");
            const unsigned og = xb_add(&bar[XB_TOP], 1u);
            const unsigned tg = og / nx;
            if (og + 1u == (tg + 1u) * nx) xb_add(&bar[XB_TOPGEN], 1u);
            else XB_SPIN(xb_ld(&bar[XB_TOPGEN]) == tg, bar);
            __builtin_amdgcn_fence(__ATOMIC_ACQUIRE, "agent");
            xb_add(&bar[XB_XGEN(b.x)], 1u);
            asm volatile("s_waitcnt vmcnt(0)" ::: "memory");
        } else {
            XB_SPIN(xb_ld(&bar[XB_XGEN(b.x)]) == gen, bar);
            __builtin_amdgcn_fence(__ATOMIC_ACQUIRE, "agent");
            asm volatile("s_waitcnt vmcnt(0)" ::: "memory");
        }
    }
    __syncthreads();
}

struct Args { const float* in[24]; float* out; unsigned char* ws; int ph_lo, ph_hi; };
enum { I_XP = 0, I_XS, I_CP, I_CS, I_CCONV, I_CK, I_CV, I_N1G, I_N2G, I_WADA, I_BADA, I_WIN, I_WDW, I_BDW, I_LNG, I_LNB, I_WCO, I_QG, I_KG, I_RB, I_WAO, I_WO, I_WF1, I_WF2 };
constexpr int NPHASE = 8;

__global__ void __launch_bounds__(NTHREADS, 2) fwd_mega(Args a) {
    extern __shared__ __attribute__((aligned(16))) unsigned char lds_raw[];
    LAS unsigned char* lds = (LAS unsigned char*)lds_raw;
    cg::grid_group grid = cg::this_grid();
    const int tid = threadIdx.x, lane = tid & 63, wave = __builtin_amdgcn_readfirstlane(tid >> 6);
    const int G = gridDim.x, bx = blockIdx.x;
    const int vcu = (G % 8 == 0) ? (bx % 8) * (G / 8) + bx / 8 : bx;
    const int gw = vcu * NWAVES + wave, NGW = G * NWAVES;
    unsigned char* ws = a.ws; float* out = a.out;
    float* MOD = (float*)(ws + WS_MOD); float* CVEC = (float*)(ws + WS_CVEC); float* SS = (float*)(ws + WS_SS);
    bf16_t *WC = (bf16_t*)(ws + WS_WC), *WA = (bf16_t*)(ws + WS_WA), *WO = (bf16_t*)(ws + WS_WO), *WF1 = (bf16_t*)(ws + WS_WF1), *WF2 = (bf16_t*)(ws + WS_WF2), *WIN = (bf16_t*)(ws + WS_WIN), *WV = (bf16_t*)(ws + WS_WV);
    bf16_t *H = (bf16_t*)(ws + WS_H), *U = (bf16_t*)(ws + WS_U), *Q = (bf16_t*)(ws + WS_Q), *KB = (bf16_t*)(ws + WS_K), *VT = (bf16_t*)(ws + WS_VT), *SG = (bf16_t*)(ws + WS_SG);
    bf16_t *Y = (bf16_t*)(ws + WS_Y), *O = (bf16_t*)(ws + WS_O), *M1 = (bf16_t*)(ws + WS_M1), *MG = (bf16_t*)(ws + WS_MG), *A2 = (bf16_t*)(ws + WS_A2), *ACT = (bf16_t*)(ws + WS_ACT);
    const int lo = a.ph_lo, hi = a.ph_hi;
    unsigned* barw = (unsigned*)(ws + WS_BAR);
    volatile LAS unsigned* bst = (volatile LAS unsigned*)(lds + LDS_BYTES - 64);
    if (tid < 2) bst[tid] = 0u;
    __syncthreads();
    XcdBarrier xbar = xcd_barrier_post(barw, bst);
    if (lo < 0) grid.sync();
#define IN(k) (lo <= (k) && (k) < hi)
#define SEAM(k) do { if (IN(k) && IN((k) + 1)) xcd_barrier(xbar); } while (0)
#ifndef PROBE_MASK
#define PROBE_MASK 0
#endif
#define REPS(k) ((((PROBE_MASK) >> (k)) & 1) + 1)
#define REPSYNC(k) do { if (rep + 1 < REPS(k)) xcd_barrier(xbar); } while (0)

    if (IN(0)) for (int rep = 0; rep < REPS(0); ++rep) {
        for (int task = bx; task < 6144 / 32; task += G) gemv34<0>(lds, task, a.in[I_WADA], 6144, a.in[I_BADA], MOD, a.in[I_CP], a.in[I_CS], nullptr, tid, lane, wave);
        LAS float* scr = (LAS float*)(lds + wave * 16640);
        constexpr int I1 = 16 * 72, I2 = 8 * 16, I3 = 8 * 16, I4 = 16 * 16, I5 = 16 * 88, I6 = 44 * 16, I7 = 32 * 8 * 8, NIT = I1 + I2 + I3 + I4 + I5 + I6 + I7;
        for (int it = gw; it < NIT; it += NGW) { int r = it;
            if (r < I1) { const int kb = r / 72, nb = r % 72, dA = win_dest(nb * 64), dB = win_dest(nb * 64 + 32);
                if (dA >= 0) tr_item(a.in[I_WIN], NIN, kb * 64, nb * 64, WIN, DM, dA, dB, scr, lane); else tr_item(a.in[I_WIN], NIN, kb * 64, nb * 64, WV, DM, -dA - 1, -dB - 1, scr, lane); continue; } r -= I1;
            if (r < I2) { tr_item(a.in[I_WCO], DM, (r / 16) * 64, (r % 16) * 64, WC, CD, (r % 16) * 64, (r % 16) * 64 + 32, scr, lane); continue; } r -= I2;
            if (r < I3) { tr_item(a.in[I_WAO], DM, (r / 16) * 64, (r % 16) * 64, WA, AD, (r % 16) * 64, (r % 16) * 64 + 32, scr, lane); continue; } r -= I3;
            if (r < I4) { tr_item(a.in[I_WO], DM, (r / 16) * 64, (r % 16) * 64, WO, DM, (r % 16) * 64, (r % 16) * 64 + 32, scr, lane); continue; } r -= I4;
            if (r < I5) { const int kb = r / 88, nb = r % 88; tr_item(a.in[I_WF1], 2 * FF, kb * 64, nb * 64, WF1, DM, ffn_dest(nb * 64), ffn_dest(nb * 64 + 32), scr, lane); continue; } r -= I5;
            if (r < I6) { tr_item(a.in[I_WF2], DM, (r / 16) * 64, (r % 16) * 64, WF2, FF, (r % 16) * 64, (r % 16) * 64 + 32, scr, lane); continue; } r -= I6;
            { const int sb = r >> 6, cc = (r >> 3) & 7, hh = r & 7;
              const float* src = a.in[I_CV] + ((size_t)sb * BANDP + cc * 64) * AD + hh * HD + (lane & 31); bf16_t* dst = VT + ((size_t)((512 + sb * 9 + cc) * NHEAD + hh)) * 4096 + lane * 8; const int hi4 = (lane >> 5) * 4;
#pragma unroll
              for (int db = 0; db < 2; ++db)
#pragma unroll
                  for (int s4 = 0; s4 < 4; ++s4) { float v[8];
#pragma unroll
                      for (int j = 0; j < 8; ++j) v[j] = src[(size_t)(16 * s4 + 8 * (j >> 2) + hi4 + (j & 3)) * AD + 32 * db];
                      *(u32x4*)(dst + (db * 4 + s4) * 512) = (u32x4){pk2(v[0], v[1]), pk2(v[2], v[3]), pk2(v[4], v[5]), pk2(v[6], v[7])}; } }
        }
#pragma unroll 4
        for (int r = gw; r < NBS * BANDP; r += NGW) { const int sb = r >> 9, i = r & 511; const float* sp = a.in[I_CK] + (size_t)r * AD + lane * 8; const int kidx = NTP + sb * SKV + i;
            *(u32x4*)(KB + ((size_t)((kidx >> 6) * NHEAD + (lane >> 3)) * 8 + ((kidx >> 5) & 1) * 4 + ((lane & 7) >> 1)) * 512 + ((lane & 1) * 32 + (kidx & 31)) * 8) = pack8(*(const f32x4*)sp, *(const f32x4*)(sp + 4)); }
        REPSYNC(0);
    }
    SEAM(0);
    if ((PROBE_MASK >> 9) & 1) { for (int e = 0; e < 8; ++e) xcd_barrier(xbar); }
    if (IN(1)) for (int rep = 0; rep < REPS(1); ++rep) {
        for (int task = bx; task < (2 * FF) / 32; task += G) gemv34<1>(lds, task, a.in[I_WF1], 2 * FF, nullptr, CVEC, nullptr, nullptr, MOD, tid, lane, wave);
        const float* g1 = a.in[I_N1G];
        const bool bal = (G == 256); constexpr int NGV = 176 * NWAVES, NG1 = 4 * NGV;
        const int gstart = !bal ? gw : (bx < 176 ? bx * NWAVES + wave : NG1 + (bx - 176) * NWAVES + wave), gstep = !bal ? NGW : (bx < 176 ? NGV : (256 - 176) * NWAVES), gend = (bal && bx < 176) ? NG1 : NTOK / 4;
        for (int g4 = gstart; g4 < gend; g4 += gstep) { const int row0 = 4 * g4; const float* xr = row0 < NTP ? a.in[I_XP] + (size_t)row0 * DM : a.in[I_XS] + (size_t)(row0 - NTP) * DM; const float* mb = MOD + (size_t)bid_of(row0) * 6144;
            f32x4 v[4][4];
#pragma unroll
            for (int r = 0; r < 4; ++r)
#pragma unroll
                for (int j = 0; j < 4; ++j) v[r][j] = *(const f32x4*)(xr + (size_t)r * DM + 4 * lane + 256 * j);
            f32x4 gm[4], sh[4];
#pragma unroll
            for (int j = 0; j < 4; ++j) { const int col = 4 * lane + 256 * j; gm[j] = *(const f32x4*)(g1 + col) * (*(const f32x4*)(mb + 1024 + col) + 1.f); sh[j] = *(const f32x4*)(mb + col); }
#pragma unroll
            for (int r = 0; r < 4; ++r) { float ss = 0.f;
#pragma unroll
                for (int j = 0; j < 4; ++j) ss += (v[r][j][0] * v[r][j][0] + v[r][j][1] * v[r][j][1]) + (v[r][j][2] * v[r][j][2] + v[r][j][3] * v[r][j][3]);
                const float rstd = rsqrtf(wave_sum(ss) * (1.f / DM) + EPS);
#pragma unroll
                for (int j = 0; j < 4; ++j) { const f32x4 hh = v[r][j] * rstd * gm[j] + sh[j];
                    *(u32x2*)(H + (size_t)(row0 + r) * DM + 4 * lane + 256 * j) = (u32x2){pk2(hh[0], hh[1]), pk2(hh[2], hh[3])}; } } }
        REPSYNC(1);
    }
    SEAM(1);
    if (IN(2)) for (int rep = 0; rep < REPS(2); ++rep) {
        pg8::Gemm g{WIN, WIN, NTOK, 4096, DM}; OrderIn S; S.init(G, bx);
        EpiIn E{U, Q, KB, VT, SG, out, a.in[I_QG], a.in[I_KG]};
        pg8::gemm_phase<EpiIn, OrderIn, true, true>(lds, g, S, E);
        REPSYNC(2);
    }
    SEAM(2);
    if (IN(3)) {
        const bool cbal = (G == 256); const int cfirst = !cbal ? bx : (vcu < 64 ? 960 + vcu : vcu - 64), cstep = !cbal ? G : (vcu < 64 ? 64 : 192), cend = (cbal && vcu >= 64) ? 960 : 1024 + 64;
        for (int rep = 0; rep < REPS(3); ++rep)
        for (int cu = cfirst; cu < cend; cu += cstep) conv_unit(cu, lds, U, a.in[I_CCONV], a.in[I_WDW], a.in[I_BDW], a.in[I_LNG], a.in[I_LNB], Y, out, tid, lane, wave);
        LAS float* rb = (LAS float*)lds;
        for (int idx = tid; idx < NHEAD * 257; idx += NTHREADS) rb[idx] = (a.in[I_RB][idx] - a.in[I_RB][(idx / 257) * 257 + 256]) * LOG2E;
        __syncthreads();
        for (int rep = 0; rep < REPS(8); ++rep)
        for (int wu = gw; wu < 8192 + 512; wu += NGW) attn_unit(wu, Q, KB, VT, O, rb, lane);
        __syncthreads();
    }
    SEAM(3);
    if (IN(4)) for (int rep = 0; rep < REPS(4); ++rep) {
        static_assert(WS_O - WS_Y == (size_t)NROWT * 256 * CD * 2 && WS_WA - WS_WC == (size_t)4 * 256 * CD * 2, "concatenated [Y | O] and [Wc | Wa] tile spaces");
        PairOrder S; S.init(NTOK, DM, G, bx); pg8::Gemm g{Y, WC, NTOK, DM, CD}; EpiMergeFused E{SG, MG};
        pg8::gemm_phase<EpiMergeFused, PairOrder, true, true>(lds, g, S, E);
        REPSYNC(4);
    }
    SEAM(4);
    if (IN(5)) for (int rep = 0; rep < REPS(5); ++rep) {
        pg8::TailOrder S; S.init(NTOK, DM, G, bx); pg8::Gemm g{MG, WO, NTOK, DM, DM};
        EpiX1 E{a.in[I_XP], a.in[I_XS], MOD, a.in[I_N2G], (bf16_t*)(ws + WS_X1), A2, SS};
        pg8::gemm_phase<EpiX1, pg8::TailOrder, true, true>(lds, g, S, E);
        REPSYNC(5);
    }
    SEAM(5);
    if (IN(6)) for (int rep = 0; rep < REPS(6); ++rep) {
        pg8::StaticOrder S; S.init(NTOK, 2 * FF, G, bx); pg8::Gemm g{A2, WF1, NTOK, 2 * FF, DM};
        EpiFfn E{SS, CVEC, ACT};
        pg8::gemm_phase<EpiFfn, pg8::StaticOrder, true, true>(lds, g, S, E);
        REPSYNC(6);
    }
    SEAM(6);
    if (IN(7)) {
        pg8::TailOrder S; S.init(NTOK, DM, G, bx); pg8::Gemm g{ACT, WF2, NTOK, DM, FF};
        EpiOut E{MOD, (const bf16_t*)(ws + WS_X1), out + OUT_Y};
        pg8::gemm_phase<EpiOut, pg8::TailOrder, true, true>(lds, g, S, E);
    }
#undef IN
#undef SEAM
}

#ifndef MK_SPLIT
#define MK_SPLIT 0
#endif
extern "C" void kernel_launch(void* const* d_in, const int* in_sizes, int n_in, void* d_out, int out_size, void* d_ws, size_t ws_size, hipStream_t stream) {
    static int grid = 0;
    if (grid == 0) {
        if (n_in != 24 || out_size != (int)OUT_END || ws_size < WS_END) { fprintf(stderr, "kernel_launch: unexpected problem (n_in %d, out %d, ws %zu)\n", n_in, out_size, ws_size); grid = -1; return; }
        int dev = 0, cus = 0, per_cu = 0;
        hipGetDevice(&dev); hipDeviceGetAttribute(&cus, hipDeviceAttributeMultiprocessorCount, dev);
        hipFuncSetAttribute((const void*)fwd_mega, hipFuncAttributeMaxDynamicSharedMemorySize, LDS_BYTES);
        hipOccupancyMaxActiveBlocksPerMultiprocessor(&per_cu, (const void*)fwd_mega, NTHREADS, LDS_BYTES);
        if (per_cu < 1) { fprintf(stderr, "kernel_launch: occupancy query says %d blocks per CU\n", per_cu); grid = -1; return; }
        grid = cus * 1;
    }
    if (grid < 0) return;
    Args a{};
    for (int i = 0; i < 24; ++i) a.in[i] = (const float*)d_in[i];
    a.out = (float*)d_out; a.ws = (unsigned char*)d_ws;
#if MK_SPLIT
    for (int p = 0; p < NPHASE; ++p) { a.ph_lo = p; a.ph_hi = p + 1; void* args[] = {&a};
        hipError_t e = hipLaunchCooperativeKernel((const void*)fwd_mega, dim3(grid), dim3(NTHREADS), args, LDS_BYTES, stream);
        if (e != hipSuccess) { fprintf(stderr, "launch %d failed: %s\n", p, hipGetErrorString(e)); break; } }
#else
    if (hipMemsetAsync((char*)d_ws + WS_BAR, 0, 16384, stream) != hipSuccess) { fprintf(stderr, "kernel_launch: memset of the barrier words failed\n"); return; }
    a.ph_lo = 0; a.ph_hi = NPHASE; void* args[] = {&a};
    hipError_t e = hipLaunchCooperativeKernel((const void*)fwd_mega, dim3(grid), dim3(NTHREADS), args, LDS_BYTES, stream);
    if (e != hipSuccess) fprintf(stderr, "cooperative launch failed: %s (grid %d)\n", hipGetErrorString(e), grid);
#endif
}
```

```cpp
#include <hip/hip_runtime.h>
#include <hip/hip_cooperative_groups.h>
#include <cstdio>
#include <cstdint>
namespace cg = cooperative_groups;
namespace pg8 {
#define PG8_LAS __attribute__((address_space(3)))
typedef unsigned short bf16_t;
typedef short bf16x8 __attribute__((ext_vector_type(8)));
typedef float f32x4 __attribute__((ext_vector_type(4)));
typedef unsigned u32x4 __attribute__((ext_vector_type(4)));
constexpr int BM = 256, BK = 64, HALF = 128, HTB = HALF * BK * 2  , STAGE_BYTES = 8 * HTB, NXCD = 8, WGM = 8;

__host__ __device__ __forceinline__ int lds_byte(int r, int c) { const int st = (r >> 4) * 2 + (c >> 5), rr = r & 15, cc = c & 31, ob = rr * 64 + cc * 2; return st * 1024 + (ob ^ (((ob >> 9) & 1) << 5)); }
__host__ __device__ __forceinline__ void stage_rc(int b, int& R, int& C) { const int st = b / 1024, sb = b % 1024, swz = sb ^ (((sb >> 9) & 1) << 5); R = (st >> 1) * 16 + swz / 64; C = (st & 1) * 32 + (swz % 64) / 2; }
__host__ __device__ __forceinline__ int perm32(int rho) { const int n = rho >> 4, i = rho & 15; return 8 * (i >> 2) + 4 * n + (i & 3); }

struct Unit { int pm, pn, sub; };
struct Gemm { const bf16_t* A; const bf16_t* Bt; int M, N, K; };

struct StaticOrder {
    int nM, nN, nwg, G, c;
    __host__ __device__ void init(int M, int N, int G_, int c_) { nM = M / BM; nN = N / BM; nwg = nM * nN; G = G_; c = c_; }
    __host__ __device__ void map(int L, Unit& u) const {
        int wgid = L; { const int q = nwg / NXCD, r = nwg % NXCD, xcd = wgid % NXCD, off = wgid / NXCD; wgid = (xcd < r ? xcd * (q + 1) : r * (q + 1) + (xcd - r) * q) + off; }
        const int nig = WGM * nN, gid = wgid / nig, fm = gid * WGM, gsz = (nM - fm) < WGM ? (nM - fm) : WGM;
        u.pm = fm + ((wgid % nig) % gsz); u.pn = (wgid % nig) / gsz; u.sub = -1;
    }
    __host__ __device__ bool next(int i, Unit& u) const { const long L = (long)i * G + c; if (L >= nwg) return false; map((int)L, u); return true; }
    __device__ __forceinline__ void a_ready(const Unit&) const {}
    __device__ __forceinline__ void done(const Unit&) const {}
};

struct TailOrder {
    StaticOrder so; int nfull;
    __host__ __device__ void init(int M, int N, int G_, int c_) { so.init(M, N, G_, c_); nfull = (so.nwg / G_) * G_; }
    __host__ __device__ bool next(int i, Unit& u) const {
        const long L = (long)i * so.G + so.c;
        if (L < nfull) { so.map((int)L, u); return true; }
        const long Lq = L - nfull; if (Lq >= 4L * (so.nwg - nfull)) return false;
        so.map(nfull + (int)(Lq >> 2), u); u.sub = (int)(Lq & 3); return true;
    }
    __device__ __forceinline__ void a_ready(const Unit&) const {}
    __device__ __forceinline__ void done(const Unit&) const {}
};

__device__ __forceinline__ unsigned cvt_pk_bf16(float lo, float hi) { unsigned r; asm volatile("v_cvt_pk_bf16_f32 %0, %1, %2" : "=v"(r) : "v"(lo), "v"(hi)); return r; }
typedef float f32x2 __attribute__((ext_vector_type(2)));
template <class Epi, class Sched, bool ALIGN_EPI = false, bool SP2 = false>
__device__ __forceinline__ void gemm_phase(PG8_LAS unsigned char* lds, const Gemm g, const Sched& S, const Epi& E) {
    const int tid = threadIdx.x, wid = __builtin_amdgcn_readfirstlane(tid >> 6), lane = tid & 63, wr = wid >> 2, wc = wid & 3, fr = lane & 15, fq = lane >> 4;
    const int K = g.K, nt = K / BK;
    unsigned voffA[2], voffB[2];
#pragma unroll
    for (int i = 0; i < 2; ++i) { int R, C; stage_rc(tid * 16 + i * 8192, R, C); const int Rb = Epi::PERM ? ((R & ~31) + perm32(R & 31)) : R;
        voffA[i] = (unsigned)(R * K + C) * 2u; voffB[i] = (unsigned)(Rb * K + C) * 2u; }
    const size_t kstep = (size_t)(BK * 2);
    const size_t hstep = (size_t)HALF * K * 2;
    const size_t tstep = 2 * hstep;
    const unsigned ldsw = (unsigned)wid * 1024u;
    const int aoff = lds_byte(wr * 64 + fr, fq * 8), boff = lds_byte(wc * 32 + fr, fq * 8);
#define PG8_SA(b, h) (((b) * 2 + (h)) * HTB)
#define PG8_SB(b, h) ((4 + (b) * 2 + (h)) * HTB)
#define PG8_STAGE(bufoff, gbase, voff) do { _Pragma("unroll") for (int _i = 0; _i < 2; ++_i) \
        __builtin_amdgcn_global_load_lds((const unsigned*)((const char*)(gbase) + (voff)[_i]), (PG8_LAS unsigned*)(lds + (bufoff) + ldsw + _i * 8192), 16, 0, 0); } while (0)
#define PG8_LDA(dst, b, h) do { _Pragma("unroll") for (int m = 0; m < 4; ++m) _Pragma("unroll") for (int k = 0; k < 2; ++k) dst[m][k] = *(const PG8_LAS bf16x8*)(lds + PG8_SA(b, h) + aoff + m * 2048 + k * 1024); } while (0)
#define PG8_LDB(dst, b, h) do { _Pragma("unroll") for (int n = 0; n < 2; ++n) _Pragma("unroll") for (int k = 0; k < 2; ++k) dst[n][k] = *(const PG8_LAS bf16x8*)(lds + PG8_SB(b, h) + boff + n * 2048 + k * 1024); } while (0)
#define PG8_MMA(ai, bj, At, Bt) do { __builtin_amdgcn_s_setprio(1); _Pragma("unroll") for (int m = 0; m < 4; ++m) _Pragma("unroll") for (int n = 0; n < 2; ++n) _Pragma("unroll") for (int k = 0; k < 2; ++k) \
        acc[ai][bj][m][n] = __builtin_amdgcn_mfma_f32_16x16x32_bf16(Bt[n][k], At[m][k], acc[ai][bj][m][n], 0, 0, 0); __builtin_amdgcn_s_setprio(0); } while (0)
#define PG8_WAIT_V(n) asm volatile("s_waitcnt vmcnt(" #n ")" ::: "memory")
#define PG8_WAIT_L(n) asm volatile("s_waitcnt lgkmcnt(" #n ")" ::: "memory")
#define PG8_BAR __builtin_amdgcn_s_barrier()
#define PG8_SCHED __builtin_amdgcn_sched_barrier(0)
    Unit cur, nxt; int ui = 0;
    if (!S.next(0, cur)) return;
    f32x4 acc[2][2][4][2];
#pragma unroll
    for (int a = 0; a < 2; ++a)
#pragma unroll
        for (int b = 0; b < 2; ++b)
#pragma unroll
            for (int m = 0; m < 4; ++m)
#pragma unroll
                for (int n = 0; n < 2; ++n) acc[a][b][m][n] = (f32x4){0.f, 0.f, 0.f, 0.f};
    bf16x8 At[4][2], B0[2][2], B1[2][2];
#define PG8_AOFF(u) ((u).sub >= 2 ? hstep : (size_t)0)
#define PG8_BOFF(u) (((u).sub >= 0 && ((u).sub & 1)) ? hstep : (size_t)0)
    const char* cA = (const char*)g.A + (size_t)cur.pm * tstep + PG8_AOFF(cur); const char* cB = (const char*)g.Bt + (size_t)cur.pn * tstep + PG8_BOFF(cur);
    S.a_ready(cur);
    if constexpr (SP2) {
        PG8_STAGE(PG8_SB(0, 0), cB, voffB); PG8_STAGE(PG8_SB(0, 1), cB + hstep, voffB); PG8_STAGE(PG8_SA(0, 0), cA, voffA); PG8_STAGE(PG8_SA(0, 1), cA + hstep, voffA);
        if (wr == 1) PG8_BAR;
        PG8_WAIT_V(2); PG8_BAR;
        PG8_STAGE(PG8_SB(1, 0), cB + kstep, voffB); PG8_STAGE(PG8_SA(1, 0), cA + kstep, voffA); PG8_STAGE(PG8_SB(1, 1), cB + hstep + kstep, voffB);
        PG8_WAIT_V(6); PG8_BAR;
    } else {
        PG8_STAGE(PG8_SB(0, 0), cB, voffB); PG8_STAGE(PG8_SA(0, 0), cA, voffA); PG8_STAGE(PG8_SB(0, 1), cB + hstep, voffB); PG8_STAGE(PG8_SA(0, 1), cA + hstep, voffA);
        if (wr == 1) PG8_BAR;
        PG8_WAIT_V(4); PG8_BAR;
        PG8_STAGE(PG8_SB(1, 0), cB + kstep, voffB); PG8_STAGE(PG8_SA(1, 0), cA + kstep, voffA); PG8_STAGE(PG8_SB(1, 1), cB + hstep + kstep, voffB);
        PG8_WAIT_V(6); PG8_BAR;
    }
    for (;;) {
        const bool has_next = S.next(ui + 1, nxt);
        const char* nA = has_next ? (const char*)g.A + (size_t)nxt.pm * tstep + PG8_AOFF(nxt) : cA; const char* nB = has_next ? (const char*)g.Bt + (size_t)nxt.pn * tstep + PG8_BOFF(nxt) : cB;
        const bool full = cur.sub < 0;
        for (int t = 0; t < nt; t += 2) {
            const bool last = (t == nt - 2);
            const char* a1 = cA + (size_t)(t + 1) * kstep;
            const char* a2 = last ? nA : cA + (size_t)(t + 2) * kstep; const char* b2 = last ? nB : cB + (size_t)(t + 2) * kstep;
            const char* a3 = a2 + kstep; const char* b3 = b2 + kstep;
            if (last && has_next) S.a_ready(nxt);
            if constexpr (SP2) {
            PG8_LDB(B0, 0, 0); PG8_LDB(B1, 0, 1); PG8_SCHED; PG8_LDA(At, 0, 0); PG8_STAGE(PG8_SA(1, 1), a1 + hstep, voffA);
            PG8_WAIT_V(8); PG8_WAIT_L(0); PG8_BAR; PG8_MMA(0, 0, At, B0); if (full) PG8_MMA(0, 1, At, B1); PG8_BAR; PG8_SCHED;
            PG8_LDA(At, 0, 1); PG8_STAGE(PG8_SB(0, 0), b2, voffB); PG8_STAGE(PG8_SB(0, 1), b2 + hstep, voffB); PG8_STAGE(PG8_SA(0, 0), a2, voffA);
            PG8_WAIT_V(8); PG8_WAIT_L(0); PG8_BAR; if (full) { PG8_MMA(1, 0, At, B0); PG8_MMA(1, 1, At, B1); } PG8_BAR; PG8_SCHED;
            PG8_LDB(B0, 1, 0); PG8_LDB(B1, 1, 1); PG8_SCHED; PG8_LDA(At, 1, 0); PG8_STAGE(PG8_SA(0, 1), a2 + hstep, voffA);
            PG8_WAIT_V(8); PG8_WAIT_L(0); PG8_BAR; PG8_MMA(0, 0, At, B0); if (full) PG8_MMA(0, 1, At, B1); PG8_BAR; PG8_SCHED;
            PG8_LDA(At, 1, 1); PG8_STAGE(PG8_SB(1, 0), b3, voffB); PG8_STAGE(PG8_SB(1, 1), b3 + hstep, voffB); PG8_STAGE(PG8_SA(1, 0), a3, voffA);
            PG8_WAIT_V(8); PG8_WAIT_L(0); PG8_BAR; if (full) { PG8_MMA(1, 0, At, B0); PG8_MMA(1, 1, At, B1); } PG8_BAR; PG8_SCHED;
            } else {
            PG8_LDB(B0, 0, 0); PG8_SCHED; PG8_LDA(At, 0, 0); PG8_STAGE(PG8_SA(1, 1), a1 + hstep, voffA);
            PG8_WAIT_L(8); PG8_BAR; PG8_WAIT_L(0); PG8_MMA(0, 0, At, B0); PG8_BAR; PG8_SCHED;
            PG8_LDB(B1, 0, 1); PG8_STAGE(PG8_SB(0, 0), b2, voffB);
            PG8_BAR; PG8_WAIT_L(0); PG8_MMA(0, 1, At, B1); PG8_BAR;
            PG8_LDA(At, 0, 1); PG8_STAGE(PG8_SA(0, 0), a2, voffA);
            PG8_BAR; PG8_WAIT_L(0); PG8_MMA(1, 0, At, B0); PG8_BAR; PG8_SCHED;
            PG8_STAGE(PG8_SB(0, 1), b2 + hstep, voffB);
            PG8_WAIT_V(6); PG8_BAR; PG8_MMA(1, 1, At, B1); PG8_BAR;
            PG8_LDB(B0, 1, 0); PG8_SCHED; PG8_LDA(At, 1, 0); PG8_STAGE(PG8_SA(0, 1), a2 + hstep, voffA);
            PG8_WAIT_L(8); PG8_BAR; PG8_WAIT_L(0); PG8_MMA(0, 0, At, B0); PG8_BAR; PG8_SCHED;
            PG8_LDB(B1, 1, 1); PG8_STAGE(PG8_SB(1, 0), b3, voffB);
            PG8_BAR; PG8_WAIT_L(0); PG8_MMA(0, 1, At, B1); PG8_BAR;
            PG8_LDA(At, 1, 1); PG8_STAGE(PG8_SA(1, 0), a3, voffA);
            PG8_BAR; PG8_WAIT_L(0); PG8_MMA(1, 0, At, B0); PG8_BAR; PG8_SCHED;
            PG8_STAGE(PG8_SB(1, 1), b3 + hstep, voffB);
            PG8_WAIT_V(6); PG8_BAR; PG8_MMA(1, 1, At, B1); PG8_BAR;
            }
        }
        if constexpr (ALIGN_EPI) { if (wr == 0) PG8_BAR; }
        if constexpr (!Epi::AFTER_DRAIN) { E(acc, cur, wr, wc, fr, fq); S.done(cur); }
        if (!has_next) break;
        if (!E.keep_acc(cur)) {
#pragma unroll
        for (int a = 0; a < 2; ++a)
#pragma unroll
            for (int b = 0; b < 2; ++b)
#pragma unroll
                for (int m = 0; m < 4; ++m)
#pragma unroll
                    for (int n = 0; n < 2; ++n) acc[a][b][m][n] = (f32x4){0.f, 0.f, 0.f, 0.f};
        }
        cur = nxt; cA = nA; cB = nB; ++ui;
        if constexpr (ALIGN_EPI) { if (wr == 1) PG8_BAR; }
    }
    PG8_WAIT_V(0);
    if constexpr (!ALIGN_EPI) { if (wr == 0) PG8_BAR; }
    PG8_BAR;
    if constexpr (Epi::AFTER_DRAIN) { E.fused(acc, cur, wr, wc, fr, fq, lds, wid, lane); S.done(cur); }
#undef PG8_AOFF
#undef PG8_BOFF
#undef PG8_SA
#undef PG8_SB
#undef PG8_STAGE
#undef PG8_LDA
#undef PG8_LDB
#undef PG8_MMA
#undef PG8_WAIT_V
#undef PG8_WAIT_L
#undef PG8_BAR
#undef PG8_SCHED
}
}

#define LAS __attribute__((address_space(3)))
typedef unsigned short bf16_t;
typedef float f32x4 __attribute__((ext_vector_type(4)));
typedef float f32x2 __attribute__((ext_vector_type(2)));
typedef float f32x16 __attribute__((ext_vector_type(16)));
typedef short bf16x8 __attribute__((ext_vector_type(8)));
typedef short s16x4 __attribute__((ext_vector_type(4)));
typedef unsigned u32x4 __attribute__((ext_vector_type(4)));
typedef unsigned u32x2 __attribute__((ext_vector_type(2)));

constexpr int DM = 1024, TP = 16384, NBP = 2, NBS = 32, TS = 64;
constexpr int NTP = NBP * TP, NTS = NBS * TS, NTOK = NTP + NTS;
constexpr int NB = NBP + NBS;
constexpr int AD = 512, CD = 512, NHEAD = 8, HD = 64, FF = 2816, NIN = 4608, CK = 31, BANDP = 512, SKV = 576;
constexpr int NROWT = NTOK / 256;
constexpr float EPS = 1e-6f, LOG2E = 1.4426950408889634f, QSCALE = 0.125f * 1.4426950408889634f;
constexpr int NWAVES = 8, NTHREADS = 512;

constexpr size_t MiB = 1u << 20;
constexpr size_t WS_BAR = 1 * MiB + 896 * 1024  , WS_MOD = 0, WS_CVEC = 1 * MiB, WS_WC = 2 * MiB, WS_WA = 3 * MiB, WS_WO = 4 * MiB, WS_WF1 = 6 * MiB, WS_WF2 = 17 * MiB;
constexpr size_t WS_WIN = 24 * MiB, WS_H = 32 * MiB, WS_WV = 100 * MiB, WS_U = 101 * MiB, WS_Q = 135 * MiB, WS_K = 169 * MiB, WS_VT = 219 * MiB, WS_SG = 269 * MiB, WS_SS = 405 * MiB;
constexpr size_t WS_Y = 32 * MiB, WS_O = 66 * MiB, WS_M1 = 101 * MiB, WS_MG = 169 * MiB, WS_A2 = 269 * MiB, WS_X1 = 337 * MiB, WS_ACT = 32 * MiB, WS_END = 410 * MiB;
static_assert(WS_H - WS_WIN == (size_t)4096 * 1024 * 2 && WS_WV - WS_H == (size_t)NTOK * 1024 * 2, "concatenated [Win | H | Wv] tile space");
constexpr size_t OUT_Y = 0, OUT_CSP = 35651584, OUT_KSP = 35682304, OUT_VSP = 36206592, OUT_CSS = 36730880, OUT_KNS = 37222400, OUT_VNS = 38270976, OUT_END = 39319552;
constexpr int LDS_BYTES = 147456;

__device__ __forceinline__ unsigned pk2(float lo, float hi) { typedef __bf16 b2 __attribute__((ext_vector_type(2))); f32x2 v = {lo, hi}; b2 b = __builtin_convertvector(v, b2); return __builtin_bit_cast(unsigned, b); }
__device__ __forceinline__ float bf_lo(unsigned w) { return __uint_as_float(w << 16); }
__device__ __forceinline__ float bf_hi(unsigned w) { return __uint_as_float(w & 0xffff0000u); }
__device__ __forceinline__ float sigm(float x) { return __builtin_amdgcn_rcpf(1.f + __builtin_amdgcn_exp2f(-LOG2E * x)); }
__device__ __forceinline__ u32x4 pack8(f32x4 a, f32x4 b) { u32x4 w; w.x = pk2(a[0], a[1]); w.y = pk2(a[2], a[3]); w.z = pk2(b[0], b[1]); w.w = pk2(b[2], b[3]); return w; }
__device__ __forceinline__ int bid_of(int row) { return row < NTP ? (row >> 14) : NBP + ((row - NTP) >> 6); }
__device__ __forceinline__ float wave_sum(float v) {
#pragma unroll
    for (int o = 1; o < 64; o <<= 1) v += __shfl_xor(v, o);
    return v;
}
__device__ __forceinline__ float quad_sum(float v) { v += __shfl_xor(v, 16); v += __shfl_xor(v, 32); return v; }

typedef const f32x4 (&AccRef)[2][2][4][2];

struct EpiIn {
    static constexpr bool PERM = true, AFTER_DRAIN = false;
    __device__ __forceinline__ bool keep_acc(const pg8::Unit&) const { return false; }
    bf16_t *U, *Q, *K, *VT, *SG; float* out; const float *qg, *kg;
    __device__ __forceinline__ void operator()(AccRef acc, const pg8::Unit& u, int wr, int wc, int fr, int fq) const {
        if (u.pm >= 16 + NROWT) {
            const int dg0 = (u.pm - 16 - NROWT) * 256 + wr * 64 + fr, tk0 = (u.pn - 16) * 256 + wc * 32 + fq * 8;
#pragma unroll
            for (int ai = 0; ai < 2; ++ai)
#pragma unroll
                for (int m = 0; m < 4; ++m) { const int dg = dg0 + ai * 128 + m * 16;
#pragma unroll
                    for (int bj = 0; bj < 2; ++bj) { const int tok = tk0 + bj * 128; const f32x4 v0 = acc[ai][bj][m][0], v1 = acc[ai][bj][m][1]; const u32x4 w = pack8(v0, v1);
                        int kidx; float* o;
                        if (tok < NTP) { const int b = tok >> 14, t = tok & (TP - 1); kidx = tok; o = (t >= TP - BANDP) ? out + OUT_VSP + ((size_t)(b * BANDP + t - (TP - BANDP)) * AD + dg) : nullptr; }
                        else { const int ts = tok - NTP; kidx = NTP + (ts >> 6) * SKV + BANDP + (ts & 63); o = out + OUT_VNS + ((size_t)ts * AD + dg); }
                        { const int kv0 = kidx & 63; bf16_t* vp = VT + ((size_t)((kidx >> 6) * NHEAD + (dg >> 6)) * 8 + ((dg >> 5) & 1) * 4 + (kv0 >> 4)) * 512 + (dg & 31) * 8 + ((kv0 >> 3) & 1) * 4;
                          *(u32x2*)vp = (u32x2){w.x, w.y}; *(u32x2*)(vp + 256) = (u32x2){w.z, w.w}; }
                        if (o) {
#pragma unroll
                            for (int j = 0; j < 4; ++j) { o[(size_t)j * AD] = v0[j]; o[(size_t)(j + 4) * AD] = v1[j]; } }
                    } }
            return;
        }
        const int row0 = (u.pm - 16) * 256 + wr * 64 + fr, pn = u.pn, cw = wc * 32 + fq * 8;
        if (pn < 4) {
#pragma unroll
            for (int ai = 0; ai < 2; ++ai)
#pragma unroll
                for (int m = 0; m < 4; ++m) { const int row = row0 + ai * 128 + m * 16; f32x4 r0, r1;
#pragma unroll
                    for (int e = 0; e < 4; ++e) { r0[e] = acc[ai][0][m][0][e] * sigm(acc[ai][1][m][0][e]); r1[e] = acc[ai][0][m][1][e] * sigm(acc[ai][1][m][1][e]); }
                    *(u32x4*)(U + (size_t)row * CD + pn * 128 + cw) = pack8(r0, r1); }
        } else if (pn < 8) {
            const bool isk = pn >= 6; const int head = ((pn - 4) & 1) * 4 + wc; const float* g = isk ? kg : qg; const float sc = isk ? 1.f : QSCALE;
            f32x4 gv[2][2];
#pragma unroll
            for (int bj = 0; bj < 2; ++bj)
#pragma unroll
                for (int n = 0; n < 2; ++n) gv[bj][n] = *(const f32x4*)(g + bj * 32 + fq * 8 + n * 4) * sc;
#pragma unroll
            for (int ai = 0; ai < 2; ++ai)
#pragma unroll
                for (int m = 0; m < 4; ++m) { const int row = row0 + ai * 128 + m * 16; float ss = 0.f;
#pragma unroll
                    for (int bj = 0; bj < 2; ++bj)
#pragma unroll
                        for (int n = 0; n < 2; ++n) { const f32x4 v = acc[ai][bj][m][n]; ss += (v[0] * v[0] + v[1] * v[1]) + (v[2] * v[2] + v[3] * v[3]); }
                    ss = quad_sum(ss); const float rstd = rsqrtf(ss * (1.f / 64.f) + EPS);
                    f32x4 o[2][2];
#pragma unroll
                    for (int bj = 0; bj < 2; ++bj)
#pragma unroll
                        for (int n = 0; n < 2; ++n) o[bj][n] = acc[ai][bj][m][n] * rstd * gv[bj][n];
                    const int hc = head * HD + fq * 8;
                    if (!isk) {
#pragma unroll
                        for (int bj = 0; bj < 2; ++bj) *(u32x4*)(Q + (size_t)row * AD + hc + bj * 32) = pack8(o[bj][0], o[bj][1]);
                    } else {
                        size_t krow; float* fo;
                        if (row < NTP) { krow = (size_t)row; const int b = row >> 14, t = row & (TP - 1); fo = (t >= TP - BANDP) ? out + OUT_KSP + (size_t)(b * BANDP + t - (TP - BANDP)) * AD : nullptr; }
                        else { const int ts = row - NTP; krow = (size_t)NTP + (size_t)(ts >> 6) * SKV + BANDP + (ts & 63); fo = out + OUT_KNS + (size_t)ts * AD; }
#pragma unroll
                        for (int bj = 0; bj < 2; ++bj) { *(u32x4*)(K + ((size_t)((krow >> 6) * NHEAD + head) * 8 + (((int)krow >> 5) & 1) * 4 + 2 * bj + (fq >> 1)) * 512 + ((fq & 1) * 32 + ((int)krow & 31)) * 8) = pack8(o[bj][0], o[bj][1]);
                            if (fo) { *(f32x4*)(fo + hc + bj * 32) = o[bj][0]; *(f32x4*)(fo + hc + bj * 32 + 4) = o[bj][1]; } }
                    } }
        } else {
#pragma unroll
            for (int ai = 0; ai < 2; ++ai)
#pragma unroll
                for (int m = 0; m < 4; ++m) { const int row = row0 + ai * 128 + m * 16; f32x4 r[2], t2[2];
#pragma unroll
                    for (int n = 0; n < 2; ++n)
#pragma unroll
                        for (int e = 0; e < 4; ++e) { const float ec = __builtin_amdgcn_exp2f(-LOG2E * acc[ai][0][m][n][e]), ea = fminf(__builtin_amdgcn_exp2f(-LOG2E * acc[ai][1][m][n][e]), 1e30f);
                            r[n][e] = (1.f + ea) * __builtin_amdgcn_rcpf(1.f + ec); t2[n][e] = __builtin_amdgcn_rcpf(1.f + ea); }
                    *(u32x4*)(SG + (size_t)row * 2048 + (pn - 8) * 128 + cw) = pack8(r[0], r[1]);
                    *(u32x4*)(SG + (size_t)row * 2048 + 1024 + (pn - 8) * 128 + cw) = pack8(t2[0], t2[1]); }
        }
    }
};
struct OrderIn {
    pg8::StaticOrder so; int G, c;
    __device__ __forceinline__ void init(int G_, int c_) { so.init(NTOK, 4096, G_, c_); G = G_; c = c_; }
    __device__ __forceinline__ bool next(int i, pg8::Unit& u) const {
        if (so.next(i, u)) { u.pm += 16; return true; }
        const int Lv = i * G + c - NROWT * 16; if (Lv >= 2 * NROWT) return false;
        u.pm = 16 + NROWT + (Lv & 1); u.pn = 16 + (Lv >> 1); u.sub = -1; return true;
    }
    __device__ __forceinline__ void a_ready(const pg8::Unit&) const {}
    __device__ __forceinline__ void done(const pg8::Unit&) const {}
};
template <int SECOND> struct EpiMerge {
    static constexpr bool PERM = true, AFTER_DRAIN = false;
    __device__ __forceinline__ bool keep_acc(const pg8::Unit&) const { return false; }
    const bf16_t* SG; bf16_t* M1; bf16_t* MG;
    __device__ __forceinline__ void operator()(AccRef acc, const pg8::Unit& u, int wr, int wc, int fr, int fq) const {
        const bool qt = u.sub >= 0; const int roff = u.sub >= 2 ? 128 : 0, coff = (qt && (u.sub & 1)) ? 128 : 0;
        const int row0 = u.pm * 256 + roff + wr * 64 + fr, col0 = u.pn * 256 + coff + wc * 32 + fq * 8;
#pragma unroll
        for (int ai = 0; ai < 2; ++ai) { if (qt && ai) break;
#pragma unroll
            for (int m = 0; m < 4; ++m) { const int row = row0 + ai * 128 + m * 16;
#pragma unroll
                for (int bj = 0; bj < 2; ++bj) { if (qt && bj) break; const int col = col0 + bj * 128;
                    const u32x4 gw = *(const u32x4*)(SG + (size_t)row * 2048 + SECOND * 1024 + col);
                    f32x4 r0 = acc[ai][bj][m][0], r1 = acc[ai][bj][m][1];
                    r0[0] *= bf_lo(gw.x); r0[1] *= bf_hi(gw.x); r0[2] *= bf_lo(gw.y); r0[3] *= bf_hi(gw.y); r1[0] *= bf_lo(gw.z); r1[1] *= bf_hi(gw.z); r1[2] *= bf_lo(gw.w); r1[3] *= bf_hi(gw.w);
                    if (SECOND) { const u32x4 pw = *(const u32x4*)(M1 + (size_t)row * DM + col);
                        r0[0] += bf_lo(pw.x); r0[1] += bf_hi(pw.x); r0[2] += bf_lo(pw.y); r0[3] += bf_hi(pw.y); r1[0] += bf_lo(pw.z); r1[1] += bf_hi(pw.z); r1[2] += bf_lo(pw.w); r1[3] += bf_hi(pw.w);
                        *(u32x4*)(MG + (size_t)row * DM + col) = pack8(r0, r1);
                    } else *(u32x4*)(M1 + (size_t)row * DM + col) = pack8(r0, r1); } } }
    }
};
struct EpiMergeFused {
    static constexpr bool PERM = true, AFTER_DRAIN = false;
    const bf16_t* SG; bf16_t* MG;
    __device__ __forceinline__ bool keep_acc(const pg8::Unit& u) const { return u.pm < NROWT; }
    __device__ __forceinline__ void operator()(f32x4 (&acc)[2][2][4][2], const pg8::Unit& u, int wr, int wc, int fr, int fq) const {
        const bool second = u.pm >= NROWT; const int pm = second ? u.pm - NROWT : u.pm, pn = second ? u.pn - 4 : u.pn;
        const bool qt = u.sub >= 0; const int roff = u.sub >= 2 ? 128 : 0, coff = (qt && (u.sub & 1)) ? 128 : 0;
        const int row0 = pm * 256 + roff + wr * 64 + fr, col0 = pn * 256 + coff + wc * 32 + fq * 8;
        u32x4 gw[2][4][2];
        const bf16_t* gp = SG + (size_t)row0 * 2048 + (second ? 1024 : 0) + col0;
#pragma unroll
        for (int ai = 0; ai < 2; ++ai) { if (qt && ai) break;
#pragma unroll
            for (int m = 0; m < 4; ++m)
#pragma unroll
                for (int bj = 0; bj < 2; ++bj) { if (qt && bj) break; gw[ai][m][bj] = *(const u32x4*)(gp + (size_t)(ai * 128 + m * 16) * 2048 + bj * 128); } }
#pragma unroll
        for (int ai = 0; ai < 2; ++ai) { if (qt && ai) break;
#pragma unroll
            for (int m = 0; m < 4; ++m) { const int row = row0 + ai * 128 + m * 16;
#pragma unroll
                for (int bj = 0; bj < 2; ++bj) { if (qt && bj) break; const int col = col0 + bj * 128; const u32x4 g = gw[ai][m][bj];
                    const f32x4 ga = {bf_lo(g.x), bf_hi(g.x), bf_lo(g.y), bf_hi(g.y)}, gb = {bf_lo(g.z), bf_hi(g.z), bf_lo(g.w), bf_hi(g.w)};
                    if (!second) { acc[ai][bj][m][0] *= ga; acc[ai][bj][m][1] *= gb; }
                    else *(u32x4*)(MG + (size_t)row * DM + col) = pack8(acc[ai][bj][m][0] * ga, acc[ai][bj][m][1] * gb); } } }
    }
};
struct PairOrder {
    pg8::TailOrder t;
    __device__ __forceinline__ void init(int M, int N, int G_, int c_) { t.init(M, N, G_, c_); }
    __device__ __forceinline__ bool next(int i, pg8::Unit& u) const { if (!t.next(i >> 1, u)) return false; if (i & 1) { u.pm += NROWT; u.pn += 4; } return true; }
    __device__ __forceinline__ void a_ready(const pg8::Unit&) const {}
    __device__ __forceinline__ void done(const pg8::Unit&) const {}
};
struct EpiX1 {
    static constexpr bool PERM = true, AFTER_DRAIN = false;
    __device__ __forceinline__ bool keep_acc(const pg8::Unit&) const { return false; }
    const float *xp, *xs, *mod, *g2; bf16_t* X1; bf16_t* A2; float* SS;
    __device__ __forceinline__ void operator()(AccRef acc, const pg8::Unit& u, int wr, int wc, int fr, int fq) const {
        const bool qt = u.sub >= 0; const int roff = u.sub >= 2 ? 128 : 0, cq = (qt && (u.sub & 1)) ? 1 : 0;
        const int col0 = u.pn * 256 + cq * 128 + wc * 32 + fq * 8, rowa0 = u.pm * 256 + roff + wr * 64, b0 = bid_of(rowa0), b1 = bid_of(rowa0 + 128);
        f32x4 gt[2][2], gs[2][2];
#pragma unroll
        for (int bj = 0; bj < 2; ++bj) { if (qt && bj) break;
#pragma unroll
            for (int n = 0; n < 2; ++n) { const int col = col0 + bj * 128 + n * 4; const float* mb = mod + (size_t)b0 * 6144; gt[bj][n] = *(const f32x4*)(mb + 2048 + col); gs[bj][n] = *(const f32x4*)(g2 + col) * (*(const f32x4*)(mb + 4096 + col) + 1.f); } }
#pragma unroll
        for (int ai = 0; ai < 2; ++ai) { if (qt && ai) break; const int rowa = rowa0 + ai * 128;
            if (ai == 1 && b1 != b0) {
#pragma unroll
                for (int bj = 0; bj < 2; ++bj)
#pragma unroll
                    for (int n = 0; n < 2; ++n) { const int col = col0 + bj * 128 + n * 4; const float* mb = mod + (size_t)b1 * 6144; gt[bj][n] = *(const f32x4*)(mb + 2048 + col); gs[bj][n] = *(const f32x4*)(g2 + col) * (*(const f32x4*)(mb + 4096 + col) + 1.f); } }
#pragma unroll
            for (int mp = 0; mp < 2; ++mp) {
                f32x4 xv[2][2][2];
#pragma unroll
                for (int mm = 0; mm < 2; ++mm) { const int row = rowa + (2 * mp + mm) * 16 + fr; const float* xr = row < NTP ? xp + (size_t)row * DM : xs + (size_t)(row - NTP) * DM;
#pragma unroll
                    for (int bj = 0; bj < 2; ++bj) { if (qt && bj) break;
#pragma unroll
                        for (int n = 0; n < 2; ++n) xv[mm][bj][n] = *(const f32x4*)(xr + col0 + bj * 128 + n * 4); } }
#pragma unroll
                for (int mm = 0; mm < 2; ++mm) { const int m = 2 * mp + mm, row = rowa + m * 16 + fr;
#pragma unroll
                    for (int bj = 0; bj < 2; ++bj) { if (qt && bj) break; f32x4 x1[2]; float ss = 0.f;
#pragma unroll
                        for (int n = 0; n < 2; ++n) { x1[n] = xv[mm][bj][n] + gt[bj][n] * acc[ai][bj][m][n];
                            ss += (x1[n][0] * x1[n][0] + x1[n][1] * x1[n][1]) + (x1[n][2] * x1[n][2] + x1[n][3] * x1[n][3]); }
                        *(u32x4*)(X1 + (size_t)row * DM + col0 + bj * 128) = pack8(x1[0], x1[1]);
                        *(u32x4*)(A2 + (size_t)row * DM + col0 + bj * 128) = pack8(x1[0] * gs[bj][0], x1[1] * gs[bj][1]);
                        ss = quad_sum(ss); if (fq == 0) SS[(size_t)row * 32 + u.pn * 8 + (cq + bj) * 4 + wc] = ss; } } } }
    }
};
struct EpiFfn {
    static constexpr bool PERM = true, AFTER_DRAIN = false;
    __device__ __forceinline__ bool keep_acc(const pg8::Unit&) const { return false; }
    const float *SS, *cvec; bf16_t* ACT;
    __device__ __forceinline__ void operator()(AccRef acc, const pg8::Unit& u, int wr, int wc, int fr, int fq) const {
        const int cl = u.pn * 128 + wc * 32 + fq * 8, rowa0 = u.pm * 256 + wr * 64, b0 = bid_of(rowa0), b1 = bid_of(rowa0 + 128);
        f32x4 pt[2][4], pu[2][4];
#pragma unroll
        for (int ai = 0; ai < 2; ++ai)
#pragma unroll
            for (int m = 0; m < 4; ++m) { const float* sp = SS + (size_t)(rowa0 + ai * 128 + m * 16 + fr) * 32 + fq * 8; pt[ai][m] = *(const f32x4*)sp; pu[ai][m] = *(const f32x4*)(sp + 4); }
        const float* cb = cvec + (size_t)b0 * (2 * FF) + cl;
        f32x4 cg0 = *(const f32x4*)(cb), cg1 = *(const f32x4*)(cb + 4), cu0 = *(const f32x4*)(cb + FF), cu1 = *(const f32x4*)(cb + FF + 4);
#pragma unroll
        for (int ai = 0; ai < 2; ++ai) {
            if (ai == 1 && b1 != b0) { const float* c1 = cvec + (size_t)b1 * (2 * FF) + cl; cg0 = *(const f32x4*)(c1); cg1 = *(const f32x4*)(c1 + 4); cu0 = *(const f32x4*)(c1 + FF); cu1 = *(const f32x4*)(c1 + FF + 4); }
#pragma unroll
            for (int m = 0; m < 4; ++m) { const int row = rowa0 + ai * 128 + m * 16 + fr; const f32x4 a4 = pt[ai][m], b4 = pu[ai][m];
                const float rstd = rsqrtf(quad_sum(((a4[0] + a4[1]) + (a4[2] + a4[3])) + ((b4[0] + b4[1]) + (b4[2] + b4[3]))) * (1.f / DM) + EPS);
                const f32x4 g0 = acc[ai][0][m][0] * rstd + cg0, g1 = acc[ai][0][m][1] * rstd + cg1, u0 = acc[ai][1][m][0] * rstd + cu0, u1 = acc[ai][1][m][1] * rstd + cu1; f32x4 r0, r1;
#pragma unroll
                for (int e = 0; e < 4; ++e) { r0[e] = g0[e] * sigm(g0[e]) * u0[e]; r1[e] = g1[e] * sigm(g1[e]) * u1[e]; }
                *(u32x4*)(ACT + (size_t)row * FF + cl) = pack8(r0, r1); } }
    }
};
struct EpiOut {
    static constexpr bool PERM = true, AFTER_DRAIN = false;
    __device__ __forceinline__ bool keep_acc(const pg8::Unit&) const { return false; }
    const float* mod; const bf16_t* X1; float* Y;
    __device__ __forceinline__ void operator()(AccRef acc, const pg8::Unit& u, int wr, int wc, int fr, int fq) const {
        const bool qt = u.sub >= 0; const int roff = u.sub >= 2 ? 128 : 0, coff = (qt && (u.sub & 1)) ? 128 : 0;
        const int col0 = u.pn * 256 + coff + wc * 32 + fq * 8, rowa0 = u.pm * 256 + roff + wr * 64, b0 = bid_of(rowa0), b1 = bid_of(rowa0 + 128);
        u32x4 xw[2][4][2];
#pragma unroll
        for (int ai = 0; ai < 2; ++ai) { if (qt && ai) break;
#pragma unroll
            for (int m = 0; m < 4; ++m)
#pragma unroll
                for (int bj = 0; bj < 2; ++bj) { if (qt && bj) break; xw[ai][m][bj] = *(const u32x4*)(X1 + (size_t)(rowa0 + ai * 128 + m * 16 + fr) * DM + col0 + bj * 128); } }
        f32x4 gt[2][2];
#pragma unroll
        for (int bj = 0; bj < 2; ++bj) { if (qt && bj) break; const float* mb = mod + (size_t)b0 * 6144 + 5120 + col0 + bj * 128; gt[bj][0] = *(const f32x4*)mb; gt[bj][1] = *(const f32x4*)(mb + 4); }
#pragma unroll
        for (int ai = 0; ai < 2; ++ai) { if (qt && ai) break;
            if (ai == 1 && b1 != b0) {
#pragma unroll
                for (int bj = 0; bj < 2; ++bj) { const float* mb = mod + (size_t)b1 * 6144 + 5120 + col0 + bj * 128; gt[bj][0] = *(const f32x4*)mb; gt[bj][1] = *(const f32x4*)(mb + 4); } }
#pragma unroll
            for (int m = 0; m < 4; ++m) { const size_t ro = (size_t)(rowa0 + ai * 128 + m * 16 + fr) * DM;
#pragma unroll
                for (int bj = 0; bj < 2; ++bj) { if (qt && bj) break; const int col = col0 + bj * 128; const u32x4 w = xw[ai][m][bj];
                    *(f32x4*)(Y + ro + col) = (f32x4){bf_lo(w.x), bf_hi(w.x), bf_lo(w.y), bf_hi(w.y)} + gt[bj][0] * acc[ai][bj][m][0];
                    *(f32x4*)(Y + ro + col + 4) = (f32x4){bf_lo(w.z), bf_hi(w.z), bf_lo(w.w), bf_hi(w.w)} + gt[bj][1] * acc[ai][bj][m][1]; } } }
    }
};

__device__ __forceinline__ void tr_item(const float* W, int N, int k0, int n0, bf16_t* WT, size_t ldo, int drowA, int drowB, LAS float* scr, int lane) {
    f32x4 v[16];
    const float* wp = W + (size_t)(k0 + (lane >> 4)) * N + n0 + (lane & 15) * 4;
#pragma unroll
    for (int i = 0; i < 16; ++i) v[i] = *(const f32x4*)(wp + (size_t)(4 * i) * N);
#pragma unroll
    for (int i = 0; i < 16; ++i) { LAS float* d = scr + (4 * i + (lane >> 4)) * 65 + (lane & 15) * 4; d[0] = v[i][0]; d[1] = v[i][1]; d[2] = v[i][2]; d[3] = v[i][3]; }
    asm volatile("s_waitcnt lgkmcnt(0)" ::: "memory");
    const int c = lane & 7;
#pragma unroll
    for (int j = 0; j < 8; ++j) { const int n = (lane >> 3) + 8 * j; const LAS float* sp = scr + (8 * c) * 65 + n;
        u32x4 o; o.x = pk2(sp[0 * 65], sp[1 * 65]); o.y = pk2(sp[2 * 65], sp[3 * 65]); o.z = pk2(sp[4 * 65], sp[5 * 65]); o.w = pk2(sp[6 * 65], sp[7 * 65]);
        const int drow = (j < 4 ? drowA + n : drowB + n - 32);
        *(u32x4*)(WT + (size_t)drow * ldo + k0 + 8 * c) = o; }
    asm volatile("s_waitcnt lgkmcnt(0)" ::: "memory");
}
__device__ __forceinline__ int win_dest(int n0) {
    if (n0 < 512) return 256 * (n0 >> 7) + (n0 & 127);
    if (n0 < 1024) { const int n = n0 - 512; return 256 * (n >> 7) + 128 + (n & 127); }
    if (n0 < 2048) { const int base = n0 < 1536 ? 1024 : 1536, n = n0 - base; return base + 256 * (n >> 8) + 128 * ((n & 63) >> 5) + 32 * ((n & 255) >> 6); }
    if (n0 < 2560) return -(n0 - 2048) - 1;
    if (n0 < 3584) { const int n = n0 - 2560; return 2048 + 256 * (n >> 7) + (n & 127); }
    { const int n = n0 - 3584; return 2048 + 256 * (n >> 7) + 128 + (n & 127); }
}
__device__ __forceinline__ int ffn_dest(int n0) { if (n0 < FF) return 256 * (n0 >> 7) + (n0 & 127); const int n = n0 - FF; return 256 * (n >> 7) + 128 + (n & 127); }

template <int MODE> __device__ __forceinline__ void gemv34(LAS unsigned char* lds, int task, const float* W, int N, const float* bias, float* out, const float* cp, const float* cs, const float* mod, int tid, int lane, int wave) {
    LAS float* S = (LAS float*)lds;
    { f32x2 sv[NB];
#pragma unroll
      for (int b = 0; b < NB; ++b) sv[b] = MODE == 0 ? *(const f32x2*)((b < NBP ? cp + b * DM : cs + (b - NBP) * DM) + 2 * tid) : *(const f32x2*)(mod + (size_t)b * 6144 + 3072 + 2 * tid);
#pragma unroll
      for (int b = 0; b < NB; ++b) { f32x2 v = sv[b]; if (MODE == 0) { v[0] *= sigm(v[0]); v[1] *= sigm(v[1]); } *(LAS f32x2*)(S + b * DM + 2 * tid) = v; } }
    __syncthreads();
    float acc[NB];
#pragma unroll
    for (int b = 0; b < NB; ++b) acc[b] = 0.f;
    const int kbase = wave * 128 + (lane >> 5) * 64;
    const float* wp = W + (size_t)kbase * N + task * 32 + (lane & 31);
    const LAS float* sp = S + kbase;
#pragma unroll 2
    for (int k4 = 0; k4 < 16; ++k4) { const float w0 = wp[0], w1 = wp[N], w2 = wp[2 * (size_t)N], w3 = wp[3 * (size_t)N]; wp += 4 * (size_t)N;
#pragma unroll
        for (int b = 0; b < NB; ++b) { const f32x4 s4 = *(const LAS f32x4*)(sp + b * DM + 4 * k4); acc[b] += (s4[0] * w0 + s4[1] * w1) + (s4[2] * w2 + s4[3] * w3); } }
    __syncthreads();
#pragma unroll
    for (int b = 0; b < NB; ++b) S[(wave * NB + b) * 64 + lane] = acc[b];
    __syncthreads();
    for (int idx = tid; idx < NB * 32; idx += NTHREADS) { const int b = idx >> 5, c = idx & 31; float s = 0.f;
#pragma unroll
        for (int w = 0; w < NWAVES; ++w) s += S[(w * NB + b) * 64 + c] + S[(w * NB + b) * 64 + 32 + c];
        out[(size_t)b * N + task * 32 + c] = s + (bias ? bias[task * 32 + c] : 0.f); }
    __syncthreads();
}

__device__ __forceinline__ void conv_unit(int cu, LAS unsigned char* lds, const bf16_t* U, const float* cache_conv, const float* w_dw, const float* b_dw, const float* ln_g, const float* ln_b, bf16_t* Y, float* out, int tid, int lane, int wave) {
    int tokbase, t0, T, seq; const bool samp = cu >= 1024;
    if (!samp) { seq = cu >> 9; t0 = (cu & 511) * 32; tokbase = seq * TP; T = TP; } else { const int c2 = cu - 1024; seq = c2 >> 1; t0 = (c2 & 1) * 32; tokbase = NTP + seq * TS; T = TS; }
    LAS unsigned* inb = (LAS unsigned*)lds;
    LAS float* yb = (LAS float*)(lds + 63488);
    for (int r = wave; r < 62; r += NWAVES) { const int t = t0 - 30 + r;
        if (t >= 0) __builtin_amdgcn_global_load_lds((const unsigned*)(U + (size_t)(tokbase + t) * CD + lane * 8), (LAS unsigned*)(inb + r * 256), 16, 0, 0);
        else { u32x4 v = {0u, 0u, 0u, 0u};
            if (samp) { const float* cc = cache_conv + ((size_t)seq * 30 + 30 + t) * CD + lane * 8; v = pack8(*(const f32x4*)cc, *(const f32x4*)(cc + 4)); }
            *(LAS u32x4*)(inb + r * 256 + lane * 4) = v; } }
    asm volatile("s_waitcnt vmcnt(0)" ::: "memory");
    __syncthreads();
    if (t0 == T - 32) {
        float* o = out + (samp ? OUT_CSS : OUT_CSP) + (size_t)seq * 30 * CD;
        for (int idx = tid; idx < 30 * 256; idx += NTHREADS) { const int r = idx >> 8, c2 = idx & 255; const unsigned v = inb[(32 + r) * 256 + c2]; *(f32x2*)(o + (size_t)r * CD + 2 * c2) = (f32x2){bf_lo(v), bf_hi(v)}; }
    }
    { const int cp = tid & 255, half = tid >> 8;
      f32x2 w[CK];
#pragma unroll
      for (int j = 0; j < CK; ++j) w[j] = *(const f32x2*)(w_dw + j * CD + 2 * cp);
      const f32x2 bb = *(const f32x2*)(b_dw + 2 * cp);
      f32x2 acc[16];
#pragma unroll
      for (int o = 0; o < 16; ++o) acc[o] = bb;
      const LAS unsigned* ip = inb + (16 * half) * 256 + cp; unsigned vc = ip[0], vn = 0u;
#pragma unroll
      for (int i = 0; i < 46; ++i) { if (i + 1 < 46) vn = ip[(i + 1) * 256]; const f32x2 x = {bf_lo(vc), bf_hi(vc)};
#pragma unroll
          for (int o = 0; o < 16; ++o) { const int j = i - o; if (j >= 0 && j < CK) acc[o] += w[j] * x; }
          __builtin_amdgcn_sched_barrier(0); vc = vn; }
#pragma unroll
      for (int o = 0; o < 16; ++o) *(LAS f32x2*)(yb + (16 * half + o) * CD + 2 * cp) = acc[o];
    }
    __syncthreads();
    const f32x4 g0 = *(const f32x4*)(ln_g + lane * 8), g1 = *(const f32x4*)(ln_g + lane * 8 + 4), b0 = *(const f32x4*)(ln_b + lane * 8), b1 = *(const f32x4*)(ln_b + lane * 8 + 4);
#pragma unroll
    for (int rr = 0; rr < 4; ++rr) { const int row = wave * 4 + rr;
        f32x4 v0 = *(const LAS f32x4*)(yb + row * CD + lane * 8), v1 = *(const LAS f32x4*)(yb + row * CD + lane * 8 + 4);
        const float mu = wave_sum((v0[0] + v0[1]) + (v0[2] + v0[3]) + (v1[0] + v1[1]) + (v1[2] + v1[3])) * (1.f / CD);
        v0 = v0 - mu; v1 = v1 - mu;
        const float var = wave_sum((v0[0] * v0[0] + v0[1] * v0[1]) + (v0[2] * v0[2] + v0[3] * v0[3]) + (v1[0] * v1[0] + v1[1] * v1[1]) + (v1[2] * v1[2] + v1[3] * v1[3])) * (1.f / CD);
        const float rstd = rsqrtf(var + EPS);
        v0 = v0 * rstd * g0 + b0; v1 = v1 * rstd * g1 + b1;
#pragma unroll
        for (int e = 0; e < 4; ++e) { v0[e] *= sigm(v0[e]); v1[e] *= sigm(v1[e]); }
        *(u32x4*)(Y + (size_t)(tokbase + t0 + row) * CD + lane * 8) = pack8(v0, v1); }
    __syncthreads();
}

__device__ __forceinline__ int crow(int r, int hi) { return (r & 3) + 8 * (r >> 2) + 4 * hi; }
__device__ __forceinline__ float max3f(float a, float b, float c) { float r; asm("v_max3_f32 %0, %1, %2, %3" : "=v"(r) : "v"(a), "v"(b), "v"(c)); return r; }
__device__ __forceinline__ float max2f(float a, float b) { float r; asm("v_max_f32_e32 %0, %1, %2" : "=v"(r) : "v"(a), "v"(b)); return r; }
#define MFMA32(a, b, c) __builtin_amdgcn_mfma_f32_32x32x16_bf16((a), (b), (c), 0, 0, 0)
__device__ __forceinline__ void attn_unit(int wu, const bf16_t* Q, const bf16_t* K, const bf16_t* VT, bf16_t* O, const LAS float* rb, int lane) {
    const int r32 = lane & 31, hi = lane >> 5;
    int h, qtok0, jstart, cb, half;
    if (wu < 8192) { half = wu & 1; const int n = (wu >> 1) & 255; h = (wu >> 9) & 7; const int b = wu >> 12; qtok0 = b * TP + 64 * n + 32 * half; cb = b * 256 + n - 8; jstart = n < 8 ? 8 - n : 0; }
    else { const int w2 = wu - 8192; half = w2 & 1; h = (w2 >> 1) & 7; const int sb = w2 >> 4; qtok0 = NTP + sb * TS + 32 * half; cb = 512 + sb * 9; jstart = 0; }
    const bf16_t* Kt = K + ((size_t)(cb * NHEAD + h)) * 4096 + lane * 8; const bf16_t* Vt = VT + ((size_t)(cb * NHEAD + h)) * 4096 + lane * 8;
    bf16x8 qf[4];
    { const bf16_t* qp = Q + (size_t)(qtok0 + r32) * AD + h * HD + 8 * hi;
#pragma unroll
      for (int d0 = 0; d0 < 4; ++d0) qf[d0] = *(const bf16x8*)(qp + 16 * d0); }
    const int qi = 32 * half + r32; const LAS float* rbh = rb + h * 257;
    float mref = 0.f, l = 0.f; f32x16 o0 = {}, o1 = {}, negm = {};
    bf16x8 kf[2][8];
#pragma unroll
    for (int j = 0; j < 9; ++j) {
        if (j == jstart) {
#pragma unroll
            for (int i = 0; i < 8; ++i) kf[j & 1][i] = *(const bf16x8*)(Kt + (size_t)j * 32768 + i * 512);
        }
        if (j >= jstart) {
            const bool first = (j == jstart);
            bf16x8 vf[8];
#pragma unroll
            for (int i = 0; i < 8; ++i) vf[i] = *(const bf16x8*)(Vt + (size_t)j * 32768 + i * 512);
            if (j < 8) {
#pragma unroll
                for (int i = 0; i < 8; ++i) kf[(j + 1) & 1][i] = *(const bf16x8*)(Kt + (size_t)(j + 1) * 32768 + i * 512);
            }
            f32x16 p0, p1;
            p0 = MFMA32(kf[j & 1][0], qf[0], negm); p1 = MFMA32(kf[j & 1][4], qf[0], negm);
#pragma unroll
            for (int d0 = 1; d0 < 4; ++d0) { p0 = MFMA32(kf[j & 1][d0], qf[d0], p0); p1 = MFMA32(kf[j & 1][4 + d0], qf[d0], p1); }
            asm volatile("s_nop 15\n\ts_nop 7" : "+v"(p0), "+v"(p1));
            const int c = 8 - j;
            if (c < 3) { const int base = 64 * c + qi + 128;
#pragma unroll
                for (int i = 0; i < 16; ++i) { const int kv = crow(i, hi); const int i0 = base - kv, i1 = base - kv - 32; p0[i] += rbh[i0 > 256 ? 256 : i0]; p1[i] += rbh[i1 > 256 ? 256 : i1]; }
            }
            float ma = max3f(p0[0], p0[1], p1[0]), mb = max3f(p0[2], p0[3], p1[1]); ma = max3f(ma, p1[2], p1[3]);
#pragma unroll
            for (int i = 4; i < 16; i += 4) { ma = max3f(ma, p0[i], p0[i + 1]); mb = max3f(mb, p0[i + 2], p0[i + 3]); ma = max3f(ma, p1[i], p1[i + 1]); mb = max3f(mb, p1[i + 2], p1[i + 3]); }
            float mt = max2f(ma, mb); mt = max2f(mt, __shfl_xor(mt, 32));
            if (first || __any(mt > 8.f)) { const float dl = first ? mt : fmaxf(mt, 0.f), f = first ? 1.f : __builtin_amdgcn_exp2f(-dl); mref += dl; l *= f;
#pragma unroll
                for (int i = 0; i < 16; ++i) { o0[i] *= f; o1[i] *= f; p0[i] -= dl; p1[i] -= dl; negm[i] = -mref; } }
            float ls = 0.f;
#pragma unroll
            for (int i = 0; i < 16; ++i) { p0[i] = __builtin_amdgcn_exp2f(p0[i]); p1[i] = __builtin_amdgcn_exp2f(p1[i]); ls += p0[i] + p1[i]; }
            l += ls;
            u32x4 pw[4];
#pragma unroll
            for (int s2 = 0; s2 < 2; ++s2) { pw[s2] = (u32x4){pk2(p0[8 * s2], p0[8 * s2 + 1]), pk2(p0[8 * s2 + 2], p0[8 * s2 + 3]), pk2(p0[8 * s2 + 4], p0[8 * s2 + 5]), pk2(p0[8 * s2 + 6], p0[8 * s2 + 7])};
                                             pw[2 + s2] = (u32x4){pk2(p1[8 * s2], p1[8 * s2 + 1]), pk2(p1[8 * s2 + 2], p1[8 * s2 + 3]), pk2(p1[8 * s2 + 4], p1[8 * s2 + 5]), pk2(p1[8 * s2 + 6], p1[8 * s2 + 7])}; }
#pragma unroll
            for (int s2 = 0; s2 < 4; ++s2) { const bf16x8 pa = __builtin_bit_cast(bf16x8, pw[s2]); o0 = MFMA32(vf[s2], pa, o0); o1 = MFMA32(vf[4 + s2], pa, o1); }
        }
    }
    l += __shfl_xor(l, 32); const float inv = 1.f / l;
    bf16_t* op = O + (size_t)(qtok0 + r32) * AD + h * HD + 4 * hi;
#pragma unroll
    for (int g = 0; g < 4; ++g) {
        *(u32x2*)(op + 8 * g) = (u32x2){pk2(o0[4 * g] * inv, o0[4 * g + 1] * inv), pk2(o0[4 * g + 2] * inv, o0[4 * g + 3] * inv)};
        *(u32x2*)(op + 32 + 8 * g) = (u32x2){pk2(o1[4 * g] * inv, o1[4 * g + 1] * inv), pk2(o1[4 * g + 2] * inv, o1[4 * g + 3] * inv)}; }
}

#define XB_TMO      128
#define XB_XCNT(j)  (256  + 64 * (j))
#define XB_XSUB(j)  (1280 + 64 * (j))
#define XB_XGEN(j)  (2304 + 64 * (j))
#define XB_TOP      3328
#define XB_TOPGEN   3392
#define XCD_BAR_WORDS 3456
#define XB_SPIN_CAP (1u << 18)

__device__ __forceinline__ unsigned xb_ld(unsigned* p)              { return __hip_atomic_load(p, __ATOMIC_RELAXED, __HIP_MEMORY_SCOPE_AGENT); }
__device__ __forceinline__ unsigned xb_add(unsigned* p, unsigned v) { return __hip_atomic_fetch_add(p, v, __ATOMIC_RELAXED, __HIP_MEMORY_SCOPE_AGENT); }
__device__ __forceinline__ unsigned xb_xcc_id() { return (unsigned)__builtin_amdgcn_s_getreg((3 << 11) | 20) & 0xFu; }
#define XB_SPIN(cond, bar) do { unsigned _sp = 0; while (cond) { __builtin_amdgcn_s_sleep(1); \
    if ((++_sp & 255u) == 0u) { if (xb_ld(&(bar)[XB_TMO])) break; if (_sp > XB_SPIN_CAP) { atomicAdd(&(bar)[XB_TMO], 1u); break; } } } } while (0)

struct XcdBarrier {
    unsigned* bar; unsigned x;
    volatile LAS unsigned* st;
};

__device__ __forceinline__ XcdBarrier xcd_barrier_post(unsigned* bar, volatile LAS unsigned* st) {
    XcdBarrier b; b.bar = bar; b.x = xb_xcc_id(); b.st = st;
    if (threadIdx.x == 0) (void)xb_add(&bar[XB_XCNT(b.x)], 1u);
    return b;
}
__device__ __forceinline__ void xcd_barrier_complete(unsigned* bar, unsigned x, unsigned& nloc, unsigned& nx) {
    const unsigned G = gridDim.x * gridDim.y * gridDim.z;
    unsigned sum, cnt, mine, sp = 0u;
    for (;;) {
        sum = 0u; cnt = 0u; mine = 0u;
#pragma unroll
        for (unsigned j = 0; j < 16; ++j) { const unsigned c = xb_ld(&bar[XB_XCNT(j)]); sum += c; cnt += (c > 0u) ? 1u : 0u; mine = (j == x) ? c : mine; }
        if (sum == G) break;
        __builtin_amdgcn_s_sleep(1);
        if ((++sp & 255u) == 0u) { if (xb_ld(&bar[XB_TMO])) break; if (sp > XB_SPIN_CAP) { atomicAdd(&bar[XB_TMO], 1u); break; } }
    }
    nloc = mine > 0u ? mine : 1u; nx = cnt > 0u ? cnt : 1u;
}

__device__ __forceinline__ void xcd_barrier(const XcdBarrier& b) {
    asm volatile("s_waitcnt vmcnt(0)" ::: "memory");
    __syncthreads();
    if (threadIdx.x == 0) {
        unsigned* bar = b.bar;
        __builtin_amdgcn_s_waitcnt(0);
        unsigned nloc = b.st[0], nx = b.st[1];
        if (nloc == 0u) { xcd_barrier_complete(bar, b.x, nloc, nx); b.st[0] = nloc; b.st[1] = nx; }
        const unsigned old = xb_add(&bar[XB_XSUB(b.x)], 1u);
        const unsigned gen = old / nloc;
        if (old + 1u == (gen + 1u) * nloc) {
            __builtin_amdgcn_fence(__ATOMIC_RELEASE, "agent");
            asm volatile("s_waitcnt vmcnt(0)" ::: "memory");
            const unsigned og = xb_add(&bar[XB_TOP], 1u);
            const unsigned tg = og / nx;
            if (og + 1u == (tg + 1u) * nx) xb_add(&bar[XB_TOPGEN], 1u);
            else XB_SPIN(xb_ld(&bar[XB_TOPGEN]) == tg, bar);
            __builtin_amdgcn_fence(__ATOMIC_ACQUIRE, "agent");
            xb_add(&bar[XB_XGEN(b.x)], 1u);
            asm volatile("s_waitcnt vmcnt(0)" ::: "memory");
        } else {
            XB_SPIN(xb_ld(&bar[XB_XGEN(b.x)]) == gen, bar);
            __builtin_amdgcn_fence(__ATOMIC_ACQUIRE, "agent");
            asm volatile("s_waitcnt vmcnt(0)" ::: "memory");
        }
    }
    __syncthreads();
}

struct Args { const float* in[24]; float* out; unsigned char* ws; int ph_lo, ph_hi; };
enum { I_XP = 0, I_XS, I_CP, I_CS, I_CCONV, I_CK, I_CV, I_N1G, I_N2G, I_WADA, I_BADA, I_WIN, I_WDW, I_BDW, I_LNG, I_LNB, I_WCO, I_QG, I_KG, I_RB, I_WAO, I_WO, I_WF1, I_WF2 };
constexpr int NPHASE = 8;

__global__ void __launch_bounds__(NTHREADS, 2) fwd_mega(Args a) {
    extern __shared__ __attribute__((aligned(16))) unsigned char lds_raw[];
    LAS unsigned char* lds = (LAS unsigned char*)lds_raw;
    cg::grid_group grid = cg::this_grid();
    const int tid = threadIdx.x, lane = tid & 63, wave = __builtin_amdgcn_readfirstlane(tid >> 6);
    const int G = gridDim.x, bx = blockIdx.x;
    const int vcu = (G % 8 == 0) ? (bx % 8) * (G / 8) + bx / 8 : bx;
    const int gw = vcu * NWAVES + wave, NGW = G * NWAVES;
    unsigned char* ws = a.ws; float* out = a.out;
    float* MOD = (float*)(ws + WS_MOD); float* CVEC = (float*)(ws + WS_CVEC); float* SS = (float*)(ws + WS_SS);
    bf16_t *WC = (bf16_t*)(ws + WS_WC), *WA = (bf16_t*)(ws + WS_WA), *WO = (bf16_t*)(ws + WS_WO), *WF1 = (bf16_t*)(ws + WS_WF1), *WF2 = (bf16_t*)(ws + WS_WF2), *WIN = (bf16_t*)(ws + WS_WIN), *WV = (bf16_t*)(ws + WS_WV);
    bf16_t *H = (bf16_t*)(ws + WS_H), *U = (bf16_t*)(ws + WS_U), *Q = (bf16_t*)(ws + WS_Q), *KB = (bf16_t*)(ws + WS_K), *VT = (bf16_t*)(ws + WS_VT), *SG = (bf16_t*)(ws + WS_SG);
    bf16_t *Y = (bf16_t*)(ws + WS_Y), *O = (bf16_t*)(ws + WS_O), *M1 = (bf16_t*)(ws + WS_M1), *MG = (bf16_t*)(ws + WS_MG), *A2 = (bf16_t*)(ws + WS_A2), *ACT = (bf16_t*)(ws + WS_ACT);
    const int lo = a.ph_lo, hi = a.ph_hi;
    unsigned* barw = (unsigned*)(ws + WS_BAR);
    volatile LAS unsigned* bst = (volatile LAS unsigned*)(lds + LDS_BYTES - 64);
    if (tid < 2) bst[tid] = 0u;
    __syncthreads();
    XcdBarrier xbar = xcd_barrier_post(barw, bst);
    if (lo < 0) grid.sync();
#define IN(k) (lo <= (k) && (k) < hi)
#define SEAM(k) do { if (IN(k) && IN((k) + 1)) xcd_barrier(xbar); } while (0)
#ifndef PROBE_MASK
#define PROBE_MASK 0
#endif
#define REPS(k) ((((PROBE_MASK) >> (k)) & 1) + 1)
#define REPSYNC(k) do { if (rep + 1 < REPS(k)) xcd_barrier(xbar); } while (0)

    if (IN(0)) for (int rep = 0; rep < REPS(0); ++rep) {
        for (int task = bx; task < 6144 / 32; task += G) gemv34<0>(lds, task, a.in[I_WADA], 6144, a.in[I_BADA], MOD, a.in[I_CP], a.in[I_CS], nullptr, tid, lane, wave);
        LAS float* scr = (LAS float*)(lds + wave * 16640);
        constexpr int I1 = 16 * 72, I2 = 8 * 16, I3 = 8 * 16, I4 = 16 * 16, I5 = 16 * 88, I6 = 44 * 16, I7 = 32 * 8 * 8, NIT = I1 + I2 + I3 + I4 + I5 + I6 + I7;
        for (int it = gw; it < NIT; it += NGW) { int r = it;
            if (r < I1) { const int kb = r / 72, nb = r % 72, dA = win_dest(nb * 64), dB = win_dest(nb * 64 + 32);
                if (dA >= 0) tr_item(a.in[I_WIN], NIN, kb * 64, nb * 64, WIN, DM, dA, dB, scr, lane); else tr_item(a.in[I_WIN], NIN, kb * 64, nb * 64, WV, DM, -dA - 1, -dB - 1, scr, lane); continue; } r -= I1;
            if (r < I2) { tr_item(a.in[I_WCO], DM, (r / 16) * 64, (r % 16) * 64, WC, CD, (r % 16) * 64, (r % 16) * 64 + 32, scr, lane); continue; } r -= I2;
            if (r < I3) { tr_item(a.in[I_WAO], DM, (r / 16) * 64, (r % 16) * 64, WA, AD, (r % 16) * 64, (r % 16) * 64 + 32, scr, lane); continue; } r -= I3;
            if (r < I4) { tr_item(a.in[I_WO], DM, (r / 16) * 64, (r % 16) * 64, WO, DM, (r % 16) * 64, (r % 16) * 64 + 32, scr, lane); continue; } r -= I4;
            if (r < I5) { const int kb = r / 88, nb = r % 88; tr_item(a.in[I_WF1], 2 * FF, kb * 64, nb * 64, WF1, DM, ffn_dest(nb * 64), ffn_dest(nb * 64 + 32), scr, lane); continue; } r -= I5;
            if (r < I6) { tr_item(a.in[I_WF2], DM, (r / 16) * 64, (r % 16) * 64, WF2, FF, (r % 16) * 64, (r % 16) * 64 + 32, scr, lane); continue; } r -= I6;
            { const int sb = r >> 6, cc = (r >> 3) & 7, hh = r & 7;
              const float* src = a.in[I_CV] + ((size_t)sb * BANDP + cc * 64) * AD + hh * HD + (lane & 31); bf16_t* dst = VT + ((size_t)((512 + sb * 9 + cc) * NHEAD + hh)) * 4096 + lane * 8; const int hi4 = (lane >> 5) * 4;
#pragma unroll
              for (int db = 0; db < 2; ++db)
#pragma unroll
                  for (int s4 = 0; s4 < 4; ++s4) { float v[8];
#pragma unroll
                      for (int j = 0; j < 8; ++j) v[j] = src[(size_t)(16 * s4 + 8 * (j >> 2) + hi4 + (j & 3)) * AD + 32 * db];
                      *(u32x4*)(dst + (db * 4 + s4) * 512) = (u32x4){pk2(v[0], v[1]), pk2(v[2], v[3]), pk2(v[4], v[5]), pk2(v[6], v[7])}; } }
        }
#pragma unroll 4
        for (int r = gw; r < NBS * BANDP; r += NGW) { const int sb = r >> 9, i = r & 511; const float* sp = a.in[I_CK] + (size_t)r * AD + lane * 8; const int kidx = NTP + sb * SKV + i;
            *(u32x4*)(KB + ((size_t)((kidx >> 6) * NHEAD + (lane >> 3)) * 8 + ((kidx >> 5) & 1) * 4 + ((lane & 7) >> 1)) * 512 + ((lane & 1) * 32 + (kidx & 31)) * 8) = pack8(*(const f32x4*)sp, *(const f32x4*)(sp + 4)); }
        REPSYNC(0);
    }
    SEAM(0);
    if ((PROBE_MASK >> 9) & 1) { for (int e = 0; e < 8; ++e) xcd_barrier(xbar); }
    if (IN(1)) for (int rep = 0; rep < REPS(1); ++rep) {
        for (int task = bx; task < (2 * FF) / 32; task += G) gemv34<1>(lds, task, a.in[I_WF1], 2 * FF, nullptr, CVEC, nullptr, nullptr, MOD, tid, lane, wave);
        const float* g1 = a.in[I_N1G];
        const bool bal = (G == 256); constexpr int NGV = 176 * NWAVES, NG1 = 4 * NGV;
        const int gstart = !bal ? gw : (bx < 176 ? bx * NWAVES + wave : NG1 + (bx - 176) * NWAVES + wave), gstep = !bal ? NGW : (bx < 176 ? NGV : (256 - 176) * NWAVES), gend = (bal && bx < 176) ? NG1 : NTOK / 4;
#define P1_LOAD(G4, V, GM, SH) do { const int row0_ = 4 * (G4); const float* xr_ = row0_ < NTP ? a.in[I_XP] + (size_t)row0_ * DM : a.in[I_XS] + (size_t)(row0_ - NTP) * DM; const float* mb_ = MOD + (size_t)bid_of(row0_) * 6144; \
            _Pragma("unroll") for (int r = 0; r < 4; ++r) _Pragma("unroll") for (int j = 0; j < 4; ++j) V[r][j] = *(const f32x4*)(xr_ + (size_t)r * DM + 4 * lane + 256 * j); \
            _Pragma("unroll") for (int j = 0; j < 4; ++j) { const int col_ = 4 * lane + 256 * j; GM[j] = *(const f32x4*)(g1 + col_) * (*(const f32x4*)(mb_ + 1024 + col_) + 1.f); SH[j] = *(const f32x4*)(mb_ + col_); } } while (0)
        { f32x4 v[4][4], gm[4], sh[4], vn[4][4], gmn[4], shn[4];
          int g4 = gstart; if (g4 < gend) P1_LOAD(g4, v, gm, sh);
          while (g4 < gend) { const int gn = g4 + gstep; if (gn < gend) P1_LOAD(gn, vn, gmn, shn);
#pragma unroll
            for (int r = 0; r < 4; ++r) { float ss = 0.f;
#pragma unroll
                for (int j = 0; j < 4; ++j) ss += (v[r][j][0] * v[r][j][0] + v[r][j][1] * v[r][j][1]) + (v[r][j][2] * v[r][j][2] + v[r][j][3] * v[r][j][3]);
                const float rstd = rsqrtf(wave_sum(ss) * (1.f / DM) + EPS);
#pragma unroll
                for (int j = 0; j < 4; ++j) { const f32x4 hh = v[r][j] * rstd * gm[j] + sh[j];
                    *(u32x2*)(H + (size_t)(4 * g4 + r) * DM + 4 * lane + 256 * j) = (u32x2){pk2(hh[0], hh[1]), pk2(hh[2], hh[3])}; } }
#pragma unroll
            for (int r = 0; r < 4; ++r)
#pragma unroll
                for (int j = 0; j < 4; ++j) v[r][j] = vn[r][j];
#pragma unroll
            for (int j = 0; j < 4; ++j) { gm[j] = gmn[j]; sh[j] = shn[j]; }
            g4 = gn; } }
#undef P1_LOAD
        REPSYNC(1);
    }
    SEAM(1);
    if (IN(2)) for (int rep = 0; rep < REPS(2); ++rep) {
        pg8::Gemm g{WIN, WIN, NTOK, 4096, DM}; OrderIn S; S.init(G, bx);
        EpiIn E{U, Q, KB, VT, SG, out, a.in[I_QG], a.in[I_KG]};
        pg8::gemm_phase<EpiIn, OrderIn, true, true>(lds, g, S, E);
        REPSYNC(2);
    }
    SEAM(2);
    if (IN(3)) {
        const bool cbal = (G == 256); const int cfirst = !cbal ? bx : (vcu < 64 ? 960 + vcu : vcu - 64), cstep = !cbal ? G : (vcu < 64 ? 64 : 192), cend = (cbal && vcu >= 64) ? 960 : 1024 + 64;
        for (int rep = 0; rep < REPS(3); ++rep)
        for (int cu = cfirst; cu < cend; cu += cstep) conv_unit(cu, lds, U, a.in[I_CCONV], a.in[I_WDW], a.in[I_BDW], a.in[I_LNG], a.in[I_LNB], Y, out, tid, lane, wave);
        LAS float* rb = (LAS float*)lds;
        for (int idx = tid; idx < NHEAD * 257; idx += NTHREADS) rb[idx] = (a.in[I_RB][idx] - a.in[I_RB][(idx / 257) * 257 + 256]) * LOG2E;
        __syncthreads();
        for (int rep = 0; rep < REPS(8); ++rep)
        for (int wu = gw; wu < 8192 + 512; wu += NGW) attn_unit(wu, Q, KB, VT, O, rb, lane);
        __syncthreads();
    }
    SEAM(3);
    if (IN(4)) for (int rep = 0; rep < REPS(4); ++rep) {
        static_assert(WS_O - WS_Y == (size_t)NROWT * 256 * CD * 2 && WS_WA - WS_WC == (size_t)4 * 256 * CD * 2, "concatenated [Y | O] and [Wc | Wa] tile spaces");
        PairOrder S; S.init(NTOK, DM, G, bx); pg8::Gemm g{Y, WC, NTOK, DM, CD}; EpiMergeFused E{SG, MG};
        pg8::gemm_phase<EpiMergeFused, PairOrder, true, true>(lds, g, S, E);
        REPSYNC(4);
    }
    SEAM(4);
    if (IN(5)) for (int rep = 0; rep < REPS(5); ++rep) {
        pg8::TailOrder S; S.init(NTOK, DM, G, bx); pg8::Gemm g{MG, WO, NTOK, DM, DM};
        EpiX1 E{a.in[I_XP], a.in[I_XS], MOD, a.in[I_N2G], (bf16_t*)(ws + WS_X1), A2, SS};
        pg8::gemm_phase<EpiX1, pg8::TailOrder, true, true>(lds, g, S, E);
        REPSYNC(5);
    }
    SEAM(5);
    if (IN(6)) for (int rep = 0; rep < REPS(6); ++rep) {
        pg8::StaticOrder S; S.init(NTOK, 2 * FF, G, bx); pg8::Gemm g{A2, WF1, NTOK, 2 * FF, DM};
        EpiFfn E{SS, CVEC, ACT};
        pg8::gemm_phase<EpiFfn, pg8::StaticOrder, true, true>(lds, g, S, E);
        REPSYNC(6);
    }
    SEAM(6);
    if (IN(7)) {
        pg8::TailOrder S; S.init(NTOK, DM, G, bx); pg8::Gemm g{ACT, WF2, NTOK, DM, FF};
        EpiOut E{MOD, (const bf16_t*)(ws + WS_X1), out + OUT_Y};
        pg8::gemm_phase<EpiOut, pg8::TailOrder, true, true>(lds, g, S, E);
    }
#undef IN
#undef SEAM
}

#ifndef MK_SPLIT
#define MK_SPLIT 0
#endif
extern "C" void kernel_launch(void* const* d_in, const int* in_sizes, int n_in, void* d_out, int out_size, void* d_ws, size_t ws_size, hipStream_t stream) {
    static int grid = 0;
    if (grid == 0) {
        if (n_in != 24 || out_size != (int)OUT_END || ws_size < WS_END) { fprintf(stderr, "kernel_launch: unexpected problem (n_in %d, out %d, ws %zu)\n", n_in, out_size, ws_size); grid = -1; return; }
        int dev = 0, cus = 0, per_cu = 0;
        hipGetDevice(&dev); hipDeviceGetAttribute(&cus, hipDeviceAttributeMultiprocessorCount, dev);
        hipFuncSetAttribute((const void*)fwd_mega, hipFuncAttributeMaxDynamicSharedMemorySize, LDS_BYTES);
        hipOccupancyMaxActiveBlocksPerMultiprocessor(&per_cu, (const void*)fwd_mega, NTHREADS, LDS_BYTES);
        if (per_cu < 1) { fprintf(stderr, "kernel_launch: occupancy query says %d blocks per CU\n", per_cu); grid = -1; return; }
        grid = cus * 1;
    }
    if (grid < 0) return;
    Args a{};
    for (int i = 0; i < 24; ++i) a.in[i] = (const float*)d_in[i];
    a.out = (float*)d_out; a.ws = (unsigned char*)d_ws;
#if MK_SPLIT
    for (int p = 0; p < NPHASE; ++p) { a.ph_lo = p; a.ph_hi = p + 1; void* args[] = {&a};
        hipError_t e = hipLaunchCooperativeKernel((const void*)fwd_mega, dim3(grid), dim3(NTHREADS), args, LDS_BYTES, stream);
        if (e != hipSuccess) { fprintf(stderr, "launch %d failed: %s\n", p, hipGetErrorString(e)); break; } }
#else
    if (hipMemsetAsync((char*)d_ws + WS_BAR, 0, 16384, stream) != hipSuccess) { fprintf(stderr, "kernel_launch: memset of the barrier words failed\n"); return; }
    a.ph_lo = 0; a.ph_hi = NPHASE; void* args[] = {&a};
    hipError_t e = hipLaunchCooperativeKernel((const void*)fwd_mega, dim3(grid), dim3(NTHREADS), args, LDS_BYTES, stream);
    if (e != hipSuccess) fprintf(stderr, "cooperative launch failed: %s (grid %d)\n", hipGetErrorString(e), grid);
#endif
}
```

```cpp
#include <hip/hip_runtime.h>
#include <hip/hip_cooperative_groups.h>
#include <cstdio>
#include <cstdint>
namespace cg = cooperative_groups;
namespace pg8 {
#define PG8_LAS __attribute__((address_space(3)))
typedef unsigned short bf16_t;
typedef short bf16x8 __attribute__((ext_vector_type(8)));
typedef float f32x4 __attribute__((ext_vector_type(4)));
typedef unsigned u32x4 __attribute__((ext_vector_type(4)));
constexpr int BM = 256, BK = 64, HALF = 128, HTB = HALF * BK * 2  , STAGE_BYTES = 8 * HTB, NXCD = 8, WGM = 8;

__host__ __device__ __forceinline__ int lds_byte(int r, int c) { const int st = (r >> 4) * 2 + (c >> 5), rr = r & 15, cc = c & 31, ob = rr * 64 + cc * 2; return st * 1024 + (ob ^ (((ob >> 9) & 1) << 5)); }
__host__ __device__ __forceinline__ void stage_rc(int b, int& R, int& C) { const int st = b / 1024, sb = b % 1024, swz = sb ^ (((sb >> 9) & 1) << 5); R = (st >> 1) * 16 + swz / 64; C = (st & 1) * 32 + (swz % 64) / 2; }
__host__ __device__ __forceinline__ int perm32(int rho) { const int n = rho >> 4, i = rho & 15; return 8 * (i >> 2) + 4 * n + (i & 3); }

struct Unit { int pm, pn, sub; };
struct Gemm { const bf16_t* A; const bf16_t* Bt; int M, N, K; };

struct StaticOrder {
    int nM, nN, nwg, G, c;
    __host__ __device__ void init(int M, int N, int G_, int c_) { nM = M / BM; nN = N / BM; nwg = nM * nN; G = G_; c = c_; }
    __host__ __device__ void map(int L, Unit& u) const {
        int wgid = L; { const int q = nwg / NXCD, r = nwg % NXCD, xcd = wgid % NXCD, off = wgid / NXCD; wgid = (xcd < r ? xcd * (q + 1) : r * (q + 1) + (xcd - r) * q) + off; }
        const int nig = WGM * nN, gid = wgid / nig, fm = gid * WGM, gsz = (nM - fm) < WGM ? (nM - fm) : WGM;
        u.pm = fm + ((wgid % nig) % gsz); u.pn = (wgid % nig) / gsz; u.sub = -1;
    }
    __host__ __device__ bool next(int i, Unit& u) const { const long L = (long)i * G + c; if (L >= nwg) return false; map((int)L, u); return true; }
    __device__ __forceinline__ void a_ready(const Unit&) const {}
    __device__ __forceinline__ void done(const Unit&) const {}
};

struct TailOrder {
    StaticOrder so; int nfull;
    __host__ __device__ void init(int M, int N, int G_, int c_) { so.init(M, N, G_, c_); nfull = (so.nwg / G_) * G_; }
    __host__ __device__ bool next(int i, Unit& u) const {
        const long L = (long)i * so.G + so.c;
        if (L < nfull) { so.map((int)L, u); return true; }
        const long Lq = L - nfull; if (Lq >= 4L * (so.nwg - nfull)) return false;
        so.map(nfull + (int)(Lq >> 2), u); u.sub = (int)(Lq & 3); return true;
    }
    __device__ __forceinline__ void a_ready(const Unit&) const {}
    __device__ __forceinline__ void done(const Unit&) const {}
};

__host__ __device__ __forceinline__ int kpart0(int nt, int p) { return ((nt * p) / 4 + 1) & ~1; }
struct KSplitOrder {
    StaticOrder so; int nfull;
    __host__ __device__ void init(int M, int N, int G_, int c_) { so.init(M, N, G_, c_); nfull = (so.nwg / G_) * G_; }
    __host__ __device__ bool next(int i, Unit& u) const {
        const long L = (long)i * so.G + so.c;
        if (L < nfull) { so.map((int)L, u); return true; }
        const long Lq = L - nfull; if (Lq >= 4L * (so.nwg - nfull)) return false;
        so.map(nfull + (int)(Lq >> 2), u); u.sub = 8 + (int)Lq; return true;
    }
    __device__ __forceinline__ void a_ready(const Unit&) const {}
    __device__ __forceinline__ void done(const Unit&) const {}
};

__device__ __forceinline__ unsigned cvt_pk_bf16(float lo, float hi) { unsigned r; asm volatile("v_cvt_pk_bf16_f32 %0, %1, %2" : "=v"(r) : "v"(lo), "v"(hi)); return r; }
typedef float f32x2 __attribute__((ext_vector_type(2)));
template <class Epi, class Sched, bool ALIGN_EPI = false, bool SP2 = false>
__device__ __forceinline__ void gemm_phase(PG8_LAS unsigned char* lds, const Gemm g, const Sched& S, const Epi& E) {
    const int tid = threadIdx.x, wid = __builtin_amdgcn_readfirstlane(tid >> 6), lane = tid & 63, wr = wid >> 2, wc = wid & 3, fr = lane & 15, fq = lane >> 4;
    const int K = g.K, nt = K / BK;
    unsigned voffA[2], voffB[2];
#pragma unroll
    for (int i = 0; i < 2; ++i) { int R, C; stage_rc(tid * 16 + i * 8192, R, C); const int Rb = Epi::PERM ? ((R & ~31) + perm32(R & 31)) : R;
        voffA[i] = (unsigned)(R * K + C) * 2u; voffB[i] = (unsigned)(Rb * K + C) * 2u; }
    const size_t kstep = (size_t)(BK * 2);
    const size_t hstep = (size_t)HALF * K * 2;
    const size_t tstep = 2 * hstep;
    const unsigned ldsw = (unsigned)wid * 1024u;
    const int aoff = lds_byte(wr * 64 + fr, fq * 8), boff = lds_byte(wc * 32 + fr, fq * 8);
#define PG8_SA(b, h) (((b) * 2 + (h)) * HTB)
#define PG8_SB(b, h) ((4 + (b) * 2 + (h)) * HTB)
#define PG8_STAGE(bufoff, gbase, voff) do { _Pragma("unroll") for (int _i = 0; _i < 2; ++_i) \
        __builtin_amdgcn_global_load_lds((const unsigned*)((const char*)(gbase) + (voff)[_i]), (PG8_LAS unsigned*)(lds + (bufoff) + ldsw + _i * 8192), 16, 0, 0); } while (0)
#define PG8_LDA(dst, b, h) do { _Pragma("unroll") for (int m = 0; m < 4; ++m) _Pragma("unroll") for (int k = 0; k < 2; ++k) dst[m][k] = *(const PG8_LAS bf16x8*)(lds + PG8_SA(b, h) + aoff + m * 2048 + k * 1024); } while (0)
#define PG8_LDB(dst, b, h) do { _Pragma("unroll") for (int n = 0; n < 2; ++n) _Pragma("unroll") for (int k = 0; k < 2; ++k) dst[n][k] = *(const PG8_LAS bf16x8*)(lds + PG8_SB(b, h) + boff + n * 2048 + k * 1024); } while (0)
#define PG8_MMA(ai, bj, At, Bt) do { __builtin_amdgcn_s_setprio(1); _Pragma("unroll") for (int m = 0; m < 4; ++m) _Pragma("unroll") for (int n = 0; n < 2; ++n) _Pragma("unroll") for (int k = 0; k < 2; ++k) \
        acc[ai][bj][m][n] = __builtin_amdgcn_mfma_f32_16x16x32_bf16(Bt[n][k], At[m][k], acc[ai][bj][m][n], 0, 0, 0); __builtin_amdgcn_s_setprio(0); } while (0)
#define PG8_WAIT_V(n) asm volatile("s_waitcnt vmcnt(" #n ")" ::: "memory")
#define PG8_WAIT_L(n) asm volatile("s_waitcnt lgkmcnt(" #n ")" ::: "memory")
#define PG8_BAR __builtin_amdgcn_s_barrier()
#define PG8_SCHED __builtin_amdgcn_sched_barrier(0)
    Unit cur, nxt; int ui = 0;
    if (!S.next(0, cur)) return;
    f32x4 acc[2][2][4][2];
#pragma unroll
    for (int a = 0; a < 2; ++a)
#pragma unroll
        for (int b = 0; b < 2; ++b)
#pragma unroll
            for (int m = 0; m < 4; ++m)
#pragma unroll
                for (int n = 0; n < 2; ++n) acc[a][b][m][n] = (f32x4){0.f, 0.f, 0.f, 0.f};
    bf16x8 At[4][2], B0[2][2], B1[2][2];
#define PG8_AOFF(u) ((((u).sub & ~1) == 2 ? hstep : (size_t)0) + ((u).sub >= 8 ? (size_t)kpart0(nt, ((u).sub - 8) & 3) * kstep : (size_t)0))
#define PG8_BOFF(u) ((((u).sub == 1 || (u).sub == 3) ? hstep : (size_t)0) + ((u).sub >= 8 ? (size_t)kpart0(nt, ((u).sub - 8) & 3) * kstep : (size_t)0))
    const char* cA = (const char*)g.A + (size_t)cur.pm * tstep + PG8_AOFF(cur); const char* cB = (const char*)g.Bt + (size_t)cur.pn * tstep + PG8_BOFF(cur);
    S.a_ready(cur);
    if constexpr (SP2) {
        PG8_STAGE(PG8_SB(0, 0), cB, voffB); PG8_STAGE(PG8_SB(0, 1), cB + hstep, voffB); PG8_STAGE(PG8_SA(0, 0), cA, voffA); PG8_STAGE(PG8_SA(0, 1), cA + hstep, voffA);
        if (wr == 1) PG8_BAR;
        PG8_WAIT_V(2); PG8_BAR;
        PG8_STAGE(PG8_SB(1, 0), cB + kstep, voffB); PG8_STAGE(PG8_SA(1, 0), cA + kstep, voffA); PG8_STAGE(PG8_SB(1, 1), cB + hstep + kstep, voffB);
        PG8_WAIT_V(6); PG8_BAR;
    } else {
        PG8_STAGE(PG8_SB(0, 0), cB, voffB); PG8_STAGE(PG8_SA(0, 0), cA, voffA); PG8_STAGE(PG8_SB(0, 1), cB + hstep, voffB); PG8_STAGE(PG8_SA(0, 1), cA + hstep, voffA);
        if (wr == 1) PG8_BAR;
        PG8_WAIT_V(4); PG8_BAR;
        PG8_STAGE(PG8_SB(1, 0), cB + kstep, voffB); PG8_STAGE(PG8_SA(1, 0), cA + kstep, voffA); PG8_STAGE(PG8_SB(1, 1), cB + hstep + kstep, voffB);
        PG8_WAIT_V(6); PG8_BAR;
    }
    for (;;) {
        const bool has_next = S.next(ui + 1, nxt);
        const char* nA = has_next ? (const char*)g.A + (size_t)nxt.pm * tstep + PG8_AOFF(nxt) : cA; const char* nB = has_next ? (const char*)g.Bt + (size_t)nxt.pn * tstep + PG8_BOFF(nxt) : cB;
        const bool full = cur.sub < 0 || cur.sub >= 8;
        const int ntu = cur.sub >= 8 ? kpart0(nt, ((cur.sub - 8) & 3) + 1) - kpart0(nt, (cur.sub - 8) & 3) : nt;
        for (int t = 0; t < ntu; t += 2) {
            const bool last = (t == ntu - 2);
            const char* a1 = cA + (size_t)(t + 1) * kstep;
            const char* a2 = last ? nA : cA + (size_t)(t + 2) * kstep; const char* b2 = last ? nB : cB + (size_t)(t + 2) * kstep;
            const char* a3 = a2 + kstep; const char* b3 = b2 + kstep;
            if (last && has_next) S.a_ready(nxt);
            if constexpr (SP2) {
            PG8_LDB(B0, 0, 0); PG8_LDB(B1, 0, 1); PG8_SCHED; PG8_LDA(At, 0, 0); PG8_STAGE(PG8_SA(1, 1), a1 + hstep, voffA);
            PG8_WAIT_V(8); PG8_WAIT_L(0); PG8_BAR; PG8_MMA(0, 0, At, B0); if (full) PG8_MMA(0, 1, At, B1); PG8_BAR; PG8_SCHED;
            PG8_LDA(At, 0, 1); PG8_STAGE(PG8_SB(0, 0), b2, voffB); PG8_STAGE(PG8_SB(0, 1), b2 + hstep, voffB); PG8_STAGE(PG8_SA(0, 0), a2, voffA);
            PG8_WAIT_V(8); PG8_WAIT_L(0); PG8_BAR; if (full) { PG8_MMA(1, 0, At, B0); PG8_MMA(1, 1, At, B1); } PG8_BAR; PG8_SCHED;
            PG8_LDB(B0, 1, 0); PG8_LDB(B1, 1, 1); PG8_SCHED; PG8_LDA(At, 1, 0); PG8_STAGE(PG8_SA(0, 1), a2 + hstep, voffA);
            PG8_WAIT_V(8); PG8_WAIT_L(0); PG8_BAR; PG8_MMA(0, 0, At, B0); if (full) PG8_MMA(0, 1, At, B1); PG8_BAR; PG8_SCHED;
            PG8_LDA(At, 1, 1); PG8_STAGE(PG8_SB(1, 0), b3, voffB); PG8_STAGE(PG8_SB(1, 1), b3 + hstep, voffB); PG8_STAGE(PG8_SA(1, 0), a3, voffA);
            PG8_WAIT_V(8); PG8_WAIT_L(0); PG8_BAR; if (full) { PG8_MMA(1, 0, At, B0); PG8_MMA(1, 1, At, B1); } PG8_BAR; PG8_SCHED;
            } else {
            PG8_LDB(B0, 0, 0); PG8_SCHED; PG8_LDA(At, 0, 0); PG8_STAGE(PG8_SA(1, 1), a1 + hstep, voffA);
            PG8_WAIT_L(8); PG8_BAR; PG8_WAIT_L(0); PG8_MMA(0, 0, At, B0); PG8_BAR; PG8_SCHED;
            PG8_LDB(B1, 0, 1); PG8_STAGE(PG8_SB(0, 0), b2, voffB);
            PG8_BAR; PG8_WAIT_L(0); PG8_MMA(0, 1, At, B1); PG8_BAR;
            PG8_LDA(At, 0, 1); PG8_STAGE(PG8_SA(0, 0), a2, voffA);
            PG8_BAR; PG8_WAIT_L(0); PG8_MMA(1, 0, At, B0); PG8_BAR; PG8_SCHED;
            PG8_STAGE(PG8_SB(0, 1), b2 + hstep, voffB);
            PG8_WAIT_V(6); PG8_BAR; PG8_MMA(1, 1, At, B1); PG8_BAR;
            PG8_LDB(B0, 1, 0); PG8_SCHED; PG8_LDA(At, 1, 0); PG8_STAGE(PG8_SA(0, 1), a2 + hstep, voffA);
            PG8_WAIT_L(8); PG8_BAR; PG8_WAIT_L(0); PG8_MMA(0, 0, At, B0); PG8_BAR; PG8_SCHED;
            PG8_LDB(B1, 1, 1); PG8_STAGE(PG8_SB(1, 0), b3, voffB);
            PG8_BAR; PG8_WAIT_L(0); PG8_MMA(0, 1, At, B1); PG8_BAR;
            PG8_LDA(At, 1, 1); PG8_STAGE(PG8_SA(1, 0), a3, voffA);
            PG8_BAR; PG8_WAIT_L(0); PG8_MMA(1, 0, At, B0); PG8_BAR; PG8_SCHED;
            PG8_STAGE(PG8_SB(1, 1), b3 + hstep, voffB);
            PG8_WAIT_V(6); PG8_BAR; PG8_MMA(1, 1, At, B1); PG8_BAR;
            }
        }
        if constexpr (ALIGN_EPI) { if (wr == 0) PG8_BAR; }
        if constexpr (!Epi::AFTER_DRAIN) { E(acc, cur, wr, wc, fr, fq); S.done(cur); }
        if (!has_next) break;
        if (!E.keep_acc(cur)) {
#pragma unroll
        for (int a = 0; a < 2; ++a)
#pragma unroll
            for (int b = 0; b < 2; ++b)
#pragma unroll
                for (int m = 0; m < 4; ++m)
#pragma unroll
                    for (int n = 0; n < 2; ++n) acc[a][b][m][n] = (f32x4){0.f, 0.f, 0.f, 0.f};
        }
        cur = nxt; cA = nA; cB = nB; ++ui;
        if constexpr (ALIGN_EPI) { if (wr == 1) PG8_BAR; }
    }
    PG8_WAIT_V(0);
    if constexpr (!ALIGN_EPI) { if (wr == 0) PG8_BAR; }
    PG8_BAR;
    if constexpr (Epi::AFTER_DRAIN) { E.fused(acc, cur, wr, wc, fr, fq, lds, wid, lane); S.done(cur); }
#undef PG8_AOFF
#undef PG8_BOFF
#undef PG8_SA
#undef PG8_SB
#undef PG8_STAGE
#undef PG8_LDA
#undef PG8_LDB
#undef PG8_MMA
#undef PG8_WAIT_V
#undef PG8_WAIT_L
#undef PG8_BAR
#undef PG8_SCHED
}
}

#define LAS __attribute__((address_space(3)))
typedef unsigned short bf16_t;
typedef float f32x4 __attribute__((ext_vector_type(4)));
typedef float f32x2 __attribute__((ext_vector_type(2)));
typedef float f32x16 __attribute__((ext_vector_type(16)));
typedef short bf16x8 __attribute__((ext_vector_type(8)));
typedef short s16x4 __attribute__((ext_vector_type(4)));
typedef unsigned u32x4 __attribute__((ext_vector_type(4)));
typedef unsigned u32x2 __attribute__((ext_vector_type(2)));

constexpr int DM = 1024, TP = 16384, NBP = 2, NBS = 32, TS = 64;
constexpr int NTP = NBP * TP, NTS = NBS * TS, NTOK = NTP + NTS;
constexpr int NB = NBP + NBS;
constexpr int AD = 512, CD = 512, NHEAD = 8, HD = 64, FF = 2816, NIN = 4608, CK = 31, BANDP = 512, SKV = 576;
constexpr int NROWT = NTOK / 256;
constexpr float EPS = 1e-6f, LOG2E = 1.4426950408889634f, QSCALE = 0.125f * 1.4426950408889634f;
constexpr int NWAVES = 8, NTHREADS = 512;

constexpr size_t MiB = 1u << 20;
constexpr size_t WS_BAR = 1 * MiB + 896 * 1024  , WS_MOD = 0, WS_CVEC = 1 * MiB, WS_WC = 2 * MiB, WS_WA = 3 * MiB, WS_WO = 4 * MiB, WS_WF1 = 6 * MiB, WS_WF2 = 17 * MiB;
constexpr size_t WS_WIN = 24 * MiB, WS_H = 32 * MiB, WS_WV = 100 * MiB, WS_U = 101 * MiB, WS_Q = 135 * MiB, WS_K = 169 * MiB, WS_VT = 219 * MiB, WS_SG = 269 * MiB, WS_SS = 405 * MiB;
constexpr size_t WS_Y = 32 * MiB, WS_O = 66 * MiB, WS_M1 = 101 * MiB, WS_MG = 169 * MiB, WS_A2 = 269 * MiB, WS_X1 = 337 * MiB, WS_ACT = 32 * MiB, WS_PART = 410 * MiB  , WS_END = 442 * MiB;
static_assert(WS_H - WS_WIN == (size_t)4096 * 1024 * 2 && WS_WV - WS_H == (size_t)NTOK * 1024 * 2, "concatenated [Win | H | Wv] tile space");
constexpr size_t OUT_Y = 0, OUT_CSP = 35651584, OUT_KSP = 35682304, OUT_VSP = 36206592, OUT_CSS = 36730880, OUT_KNS = 37222400, OUT_VNS = 38270976, OUT_END = 39319552;
constexpr int LDS_BYTES = 147456;

__device__ __forceinline__ unsigned pk2(float lo, float hi) { typedef __bf16 b2 __attribute__((ext_vector_type(2))); f32x2 v = {lo, hi}; b2 b = __builtin_convertvector(v, b2); return __builtin_bit_cast(unsigned, b); }
__device__ __forceinline__ float bf_lo(unsigned w) { return __uint_as_float(w << 16); }
__device__ __forceinline__ float bf_hi(unsigned w) { return __uint_as_float(w & 0xffff0000u); }
__device__ __forceinline__ float sigm(float x) { return __builtin_amdgcn_rcpf(1.f + __builtin_amdgcn_exp2f(-LOG2E * x)); }
__device__ __forceinline__ u32x4 pack8(f32x4 a, f32x4 b) { u32x4 w; w.x = pk2(a[0], a[1]); w.y = pk2(a[2], a[3]); w.z = pk2(b[0], b[1]); w.w = pk2(b[2], b[3]); return w; }
__device__ __forceinline__ int bid_of(int row) { return row < NTP ? (row >> 14) : NBP + ((row - NTP) >> 6); }
__device__ __forceinline__ float wave_sum(float v) {
#pragma unroll
    for (int o = 1; o < 64; o <<= 1) v += __shfl_xor(v, o);
    return v;
}
__device__ __forceinline__ float quad_sum(float v) { v += __shfl_xor(v, 16); v += __shfl_xor(v, 32); return v; }

typedef const f32x4 (&AccRef)[2][2][4][2];

struct EpiIn {
    static constexpr bool PERM = true, AFTER_DRAIN = false;
    __device__ __forceinline__ bool keep_acc(const pg8::Unit&) const { return false; }
    bf16_t *U, *Q, *K, *VT, *SG; float* out; const float *qg, *kg;
    __device__ __forceinline__ void operator()(AccRef acc, const pg8::Unit& u, int wr, int wc, int fr, int fq) const {
        if (u.pm >= 16 + NROWT) {
            const int dg0 = (u.pm - 16 - NROWT) * 256 + wr * 64 + fr, tk0 = (u.pn - 16) * 256 + wc * 32 + fq * 8;
#pragma unroll
            for (int ai = 0; ai < 2; ++ai)
#pragma unroll
                for (int m = 0; m < 4; ++m) { const int dg = dg0 + ai * 128 + m * 16;
#pragma unroll
                    for (int bj = 0; bj < 2; ++bj) { const int tok = tk0 + bj * 128; const f32x4 v0 = acc[ai][bj][m][0], v1 = acc[ai][bj][m][1]; const u32x4 w = pack8(v0, v1);
                        int kidx; float* o;
                        if (tok < NTP) { const int b = tok >> 14, t = tok & (TP - 1); kidx = tok; o = (t >= TP - BANDP) ? out + OUT_VSP + ((size_t)(b * BANDP + t - (TP - BANDP)) * AD + dg) : nullptr; }
                        else { const int ts = tok - NTP; kidx = NTP + (ts >> 6) * SKV + BANDP + (ts & 63); o = out + OUT_VNS + ((size_t)ts * AD + dg); }
                        { const int kv0 = kidx & 63; bf16_t* vp = VT + ((size_t)((kidx >> 6) * NHEAD + (dg >> 6)) * 8 + ((dg >> 5) & 1) * 4 + (kv0 >> 4)) * 512 + (dg & 31) * 8 + ((kv0 >> 3) & 1) * 4;
                          *(u32x2*)vp = (u32x2){w.x, w.y}; *(u32x2*)(vp + 256) = (u32x2){w.z, w.w}; }
                        if (o) {
#pragma unroll
                            for (int j = 0; j < 4; ++j) { o[(size_t)j * AD] = v0[j]; o[(size_t)(j + 4) * AD] = v1[j]; } }
                    } }
            return;
        }
        const int row0 = (u.pm - 16) * 256 + wr * 64 + fr, pn = u.pn, cw = wc * 32 + fq * 8;
        if (pn < 4) {
#pragma unroll
            for (int ai = 0; ai < 2; ++ai)
#pragma unroll
                for (int m = 0; m < 4; ++m) { const int row = row0 + ai * 128 + m * 16; f32x4 r0, r1;
#pragma unroll
                    for (int e = 0; e < 4; ++e) { r0[e] = acc[ai][0][m][0][e] * sigm(acc[ai][1][m][0][e]); r1[e] = acc[ai][0][m][1][e] * sigm(acc[ai][1][m][1][e]); }
                    *(u32x4*)(U + (size_t)row * CD + pn * 128 + cw) = pack8(r0, r1); }
        } else if (pn < 8) {
            const bool isk = pn >= 6; const int head = ((pn - 4) & 1) * 4 + wc; const float* g = isk ? kg : qg; const float sc = isk ? 1.f : QSCALE;
            f32x4 gv[2][2];
#pragma unroll
            for (int bj = 0; bj < 2; ++bj)
#pragma unroll
                for (int n = 0; n < 2; ++n) gv[bj][n] = *(const f32x4*)(g + bj * 32 + fq * 8 + n * 4) * sc;
#pragma unroll
            for (int ai = 0; ai < 2; ++ai)
#pragma unroll
                for (int m = 0; m < 4; ++m) { const int row = row0 + ai * 128 + m * 16; float ss = 0.f;
#pragma unroll
                    for (int bj = 0; bj < 2; ++bj)
#pragma unroll
                        for (int n = 0; n < 2; ++n) { const f32x4 v = acc[ai][bj][m][n]; ss += (v[0] * v[0] + v[1] * v[1]) + (v[2] * v[2] + v[3] * v[3]); }
                    ss = quad_sum(ss); const float rstd = rsqrtf(ss * (1.f / 64.f) + EPS);
                    f32x4 o[2][2];
#pragma unroll
                    for (int bj = 0; bj < 2; ++bj)
#pragma unroll
                        for (int n = 0; n < 2; ++n) o[bj][n] = acc[ai][bj][m][n] * rstd * gv[bj][n];
                    const int hc = head * HD + fq * 8;
                    if (!isk) {
#pragma unroll
                        for (int bj = 0; bj < 2; ++bj) *(u32x4*)(Q + (size_t)row * AD + hc + bj * 32) = pack8(o[bj][0], o[bj][1]);
                    } else {
                        size_t krow; float* fo;
                        if (row < NTP) { krow = (size_t)row; const int b = row >> 14, t = row & (TP - 1); fo = (t >= TP - BANDP) ? out + OUT_KSP + (size_t)(b * BANDP + t - (TP - BANDP)) * AD : nullptr; }
                        else { const int ts = row - NTP; krow = (size_t)NTP + (size_t)(ts >> 6) * SKV + BANDP + (ts & 63); fo = out + OUT_KNS + (size_t)ts * AD; }
#pragma unroll
                        for (int bj = 0; bj < 2; ++bj) { *(u32x4*)(K + ((size_t)((krow >> 6) * NHEAD + head) * 8 + (((int)krow >> 5) & 1) * 4 + 2 * bj + (fq >> 1)) * 512 + ((fq & 1) * 32 + ((int)krow & 31)) * 8) = pack8(o[bj][0], o[bj][1]);
                            if (fo) { *(f32x4*)(fo + hc + bj * 32) = o[bj][0]; *(f32x4*)(fo + hc + bj * 32 + 4) = o[bj][1]; } }
                    } }
        } else {
#pragma unroll
            for (int ai = 0; ai < 2; ++ai)
#pragma unroll
                for (int m = 0; m < 4; ++m) { const int row = row0 + ai * 128 + m * 16; f32x4 r[2], t2[2];
#pragma unroll
                    for (int n = 0; n < 2; ++n)
#pragma unroll
                        for (int e = 0; e < 4; ++e) { const float ec = __builtin_amdgcn_exp2f(-LOG2E * acc[ai][0][m][n][e]), ea = fminf(__builtin_amdgcn_exp2f(-LOG2E * acc[ai][1][m][n][e]), 1e30f);
                            r[n][e] = (1.f + ea) * __builtin_amdgcn_rcpf(1.f + ec); t2[n][e] = __builtin_amdgcn_rcpf(1.f + ea); }
                    *(u32x4*)(SG + (size_t)row * 2048 + (pn - 8) * 128 + cw) = pack8(r[0], r[1]);
                    *(u32x4*)(SG + (size_t)row * 2048 + 1024 + (pn - 8) * 128 + cw) = pack8(t2[0], t2[1]); }
        }
    }
};
struct OrderIn {
    pg8::StaticOrder so; int G, c;
    __device__ __forceinline__ void init(int G_, int c_) { so.init(NTOK, 4096, G_, c_); G = G_; c = c_; }
    __device__ __forceinline__ bool next(int i, pg8::Unit& u) const {
        if (so.next(i, u)) { u.pm += 16; return true; }
        const int Lv = i * G + c - NROWT * 16; if (Lv >= 2 * NROWT) return false;
        u.pm = 16 + NROWT + (Lv & 1); u.pn = 16 + (Lv >> 1); u.sub = -1; return true;
    }
    __device__ __forceinline__ void a_ready(const pg8::Unit&) const {}
    __device__ __forceinline__ void done(const pg8::Unit&) const {}
};
template <int SECOND> struct EpiMerge {
    static constexpr bool PERM = true, AFTER_DRAIN = false;
    __device__ __forceinline__ bool keep_acc(const pg8::Unit&) const { return false; }
    const bf16_t* SG; bf16_t* M1; bf16_t* MG;
    __device__ __forceinline__ void operator()(AccRef acc, const pg8::Unit& u, int wr, int wc, int fr, int fq) const {
        const bool qt = u.sub >= 0; const int roff = u.sub >= 2 ? 128 : 0, coff = (qt && (u.sub & 1)) ? 128 : 0;
        const int row0 = u.pm * 256 + roff + wr * 64 + fr, col0 = u.pn * 256 + coff + wc * 32 + fq * 8;
#pragma unroll
        for (int ai = 0; ai < 2; ++ai) { if (qt && ai) break;
#pragma unroll
            for (int m = 0; m < 4; ++m) { const int row = row0 + ai * 128 + m * 16;
#pragma unroll
                for (int bj = 0; bj < 2; ++bj) { if (qt && bj) break; const int col = col0 + bj * 128;
                    const u32x4 gw = *(const u32x4*)(SG + (size_t)row * 2048 + SECOND * 1024 + col);
                    f32x4 r0 = acc[ai][bj][m][0], r1 = acc[ai][bj][m][1];
                    r0[0] *= bf_lo(gw.x); r0[1] *= bf_hi(gw.x); r0[2] *= bf_lo(gw.y); r0[3] *= bf_hi(gw.y); r1[0] *= bf_lo(gw.z); r1[1] *= bf_hi(gw.z); r1[2] *= bf_lo(gw.w); r1[3] *= bf_hi(gw.w);
                    if (SECOND) { const u32x4 pw = *(const u32x4*)(M1 + (size_t)row * DM + col);
                        r0[0] += bf_lo(pw.x); r0[1] += bf_hi(pw.x); r0[2] += bf_lo(pw.y); r0[3] += bf_hi(pw.y); r1[0] += bf_lo(pw.z); r1[1] += bf_hi(pw.z); r1[2] += bf_lo(pw.w); r1[3] += bf_hi(pw.w);
                        *(u32x4*)(MG + (size_t)row * DM + col) = pack8(r0, r1);
                    } else *(u32x4*)(M1 + (size_t)row * DM + col) = pack8(r0, r1); } } }
    }
};
struct EpiMergeFused {
    static constexpr bool PERM = true, AFTER_DRAIN = false;
    const bf16_t* SG; bf16_t* MG;
    __device__ __forceinline__ bool keep_acc(const pg8::Unit& u) const { return u.pm < NROWT; }
    __device__ __forceinline__ void operator()(f32x4 (&acc)[2][2][4][2], const pg8::Unit& u, int wr, int wc, int fr, int fq) const {
        const bool second = u.pm >= NROWT; const int pm = second ? u.pm - NROWT : u.pm, pn = second ? u.pn - 4 : u.pn;
        const bool qt = u.sub >= 0; const int roff = u.sub >= 2 ? 128 : 0, coff = (qt && (u.sub & 1)) ? 128 : 0;
        const int row0 = pm * 256 + roff + wr * 64 + fr, col0 = pn * 256 + coff + wc * 32 + fq * 8;
        u32x4 gw[2][4][2];
        const bf16_t* gp = SG + (size_t)row0 * 2048 + (second ? 1024 : 0) + col0;
#pragma unroll
        for (int ai = 0; ai < 2; ++ai) { if (qt && ai) break;
#pragma unroll
            for (int m = 0; m < 4; ++m)
#pragma unroll
                for (int bj = 0; bj < 2; ++bj) { if (qt && bj) break; gw[ai][m][bj] = *(const u32x4*)(gp + (size_t)(ai * 128 + m * 16) * 2048 + bj * 128); } }
#pragma unroll
        for (int ai = 0; ai < 2; ++ai) { if (qt && ai) break;
#pragma unroll
            for (int m = 0; m < 4; ++m) { const int row = row0 + ai * 128 + m * 16;
#pragma unroll
                for (int bj = 0; bj < 2; ++bj) { if (qt && bj) break; const int col = col0 + bj * 128; const u32x4 g = gw[ai][m][bj];
                    const f32x4 ga = {bf_lo(g.x), bf_hi(g.x), bf_lo(g.y), bf_hi(g.y)}, gb = {bf_lo(g.z), bf_hi(g.z), bf_lo(g.w), bf_hi(g.w)};
                    if (!second) { acc[ai][bj][m][0] *= ga; acc[ai][bj][m][1] *= gb; }
                    else *(u32x4*)(MG + (size_t)row * DM + col) = pack8(acc[ai][bj][m][0] * ga, acc[ai][bj][m][1] * gb); } } }
    }
};
struct PairOrder {
    pg8::TailOrder t;
    __device__ __forceinline__ void init(int M, int N, int G_, int c_) { t.init(M, N, G_, c_); }
    __device__ __forceinline__ bool next(int i, pg8::Unit& u) const { if (!t.next(i >> 1, u)) return false; if (i & 1) { u.pm += NROWT; u.pn += 4; } return true; }
    __device__ __forceinline__ void a_ready(const pg8::Unit&) const {}
    __device__ __forceinline__ void done(const pg8::Unit&) const {}
};
struct EpiX1 {
    static constexpr bool PERM = true, AFTER_DRAIN = false;
    __device__ __forceinline__ bool keep_acc(const pg8::Unit&) const { return false; }
    const float *xp, *xs, *mod, *g2; bf16_t* X1; bf16_t* A2; float* SS;
    __device__ __forceinline__ void operator()(AccRef acc, const pg8::Unit& u, int wr, int wc, int fr, int fq) const {
        const bool qt = u.sub >= 0; const int roff = u.sub >= 2 ? 128 : 0, cq = (qt && (u.sub & 1)) ? 1 : 0;
        const int col0 = u.pn * 256 + cq * 128 + wc * 32 + fq * 8, rowa0 = u.pm * 256 + roff + wr * 64, b0 = bid_of(rowa0), b1 = bid_of(rowa0 + 128);
        f32x4 gt[2][2], gs[2][2];
#pragma unroll
        for (int bj = 0; bj < 2; ++bj) { if (qt && bj) break;
#pragma unroll
            for (int n = 0; n < 2; ++n) { const int col = col0 + bj * 128 + n * 4; const float* mb = mod + (size_t)b0 * 6144; gt[bj][n] = *(const f32x4*)(mb + 2048 + col); gs[bj][n] = *(const f32x4*)(g2 + col) * (*(const f32x4*)(mb + 4096 + col) + 1.f); } }
#pragma unroll
        for (int ai = 0; ai < 2; ++ai) { if (qt && ai) break; const int rowa = rowa0 + ai * 128;
            if (ai == 1 && b1 != b0) {
#pragma unroll
                for (int bj = 0; bj < 2; ++bj)
#pragma unroll
                    for (int n = 0; n < 2; ++n) { const int col = col0 + bj * 128 + n * 4; const float* mb = mod + (size_t)b1 * 6144; gt[bj][n] = *(const f32x4*)(mb + 2048 + col); gs[bj][n] = *(const f32x4*)(g2 + col) * (*(const f32x4*)(mb + 4096 + col) + 1.f); } }
#pragma unroll
            for (int mp = 0; mp < 2; ++mp) {
                f32x4 xv[2][2][2];
#pragma unroll
                for (int mm = 0; mm < 2; ++mm) { const int row = rowa + (2 * mp + mm) * 16 + fr; const float* xr = row < NTP ? xp + (size_t)row * DM : xs + (size_t)(row - NTP) * DM;
#pragma unroll
                    for (int bj = 0; bj < 2; ++bj) { if (qt && bj) break;
#pragma unroll
                        for (int n = 0; n < 2; ++n) xv[mm][bj][n] = *(const f32x4*)(xr + col0 + bj * 128 + n * 4); } }
#pragma unroll
                for (int mm = 0; mm < 2; ++mm) { const int m = 2 * mp + mm, row = rowa + m * 16 + fr;
#pragma unroll
                    for (int bj = 0; bj < 2; ++bj) { if (qt && bj) break; f32x4 x1[2]; float ss = 0.f;
#pragma unroll
                        for (int n = 0; n < 2; ++n) { x1[n] = xv[mm][bj][n] + gt[bj][n] * acc[ai][bj][m][n];
                            ss += (x1[n][0] * x1[n][0] + x1[n][1] * x1[n][1]) + (x1[n][2] * x1[n][2] + x1[n][3] * x1[n][3]); }
                        *(u32x4*)(X1 + (size_t)row * DM + col0 + bj * 128) = pack8(x1[0], x1[1]);
                        *(u32x4*)(A2 + (size_t)row * DM + col0 + bj * 128) = pack8(x1[0] * gs[bj][0], x1[1] * gs[bj][1]);
                        ss = quad_sum(ss); if (fq == 0) SS[(size_t)row * 32 + u.pn * 8 + (cq + bj) * 4 + wc] = ss; } } } }
    }
};
struct EpiFfn {
    static constexpr bool PERM = true, AFTER_DRAIN = false;
    __device__ __forceinline__ bool keep_acc(const pg8::Unit&) const { return false; }
    const float *SS, *cvec; bf16_t* ACT;
    __device__ __forceinline__ void operator()(AccRef acc, const pg8::Unit& u, int wr, int wc, int fr, int fq) const {
        const int cl = u.pn * 128 + wc * 32 + fq * 8, rowa0 = u.pm * 256 + wr * 64, b0 = bid_of(rowa0), b1 = bid_of(rowa0 + 128);
        f32x4 pt[2][4], pu[2][4];
#pragma unroll
        for (int ai = 0; ai < 2; ++ai)
#pragma unroll
            for (int m = 0; m < 4; ++m) { const float* sp = SS + (size_t)(rowa0 + ai * 128 + m * 16 + fr) * 32 + fq * 8; pt[ai][m] = *(const f32x4*)sp; pu[ai][m] = *(const f32x4*)(sp + 4); }
        const float* cb = cvec + (size_t)b0 * (2 * FF) + cl;
        f32x4 cg0 = *(const f32x4*)(cb), cg1 = *(const f32x4*)(cb + 4), cu0 = *(const f32x4*)(cb + FF), cu1 = *(const f32x4*)(cb + FF + 4);
#pragma unroll
        for (int ai = 0; ai < 2; ++ai) {
            if (ai == 1 && b1 != b0) { const float* c1 = cvec + (size_t)b1 * (2 * FF) + cl; cg0 = *(const f32x4*)(c1); cg1 = *(const f32x4*)(c1 + 4); cu0 = *(const f32x4*)(c1 + FF); cu1 = *(const f32x4*)(c1 + FF + 4); }
#pragma unroll
            for (int m = 0; m < 4; ++m) { const int row = rowa0 + ai * 128 + m * 16 + fr; const f32x4 a4 = pt[ai][m], b4 = pu[ai][m];
                const float rstd = rsqrtf(quad_sum(((a4[0] + a4[1]) + (a4[2] + a4[3])) + ((b4[0] + b4[1]) + (b4[2] + b4[3]))) * (1.f / DM) + EPS);
                const f32x4 g0 = acc[ai][0][m][0] * rstd + cg0, g1 = acc[ai][0][m][1] * rstd + cg1, u0 = acc[ai][1][m][0] * rstd + cu0, u1 = acc[ai][1][m][1] * rstd + cu1; f32x4 r0, r1;
#pragma unroll
                for (int e = 0; e < 4; ++e) { r0[e] = g0[e] * sigm(g0[e]) * u0[e]; r1[e] = g1[e] * sigm(g1[e]) * u1[e]; }
                *(u32x4*)(ACT + (size_t)row * FF + cl) = pack8(r0, r1); } }
    }
};
struct EpiOut {
    static constexpr bool PERM = true, AFTER_DRAIN = false;
    __device__ __forceinline__ bool keep_acc(const pg8::Unit&) const { return false; }
    const float* mod; const bf16_t* X1; float* Y; float* PART;
    __device__ __forceinline__ void operator()(AccRef acc, const pg8::Unit& u, int wr, int wc, int fr, int fq) const {
        asm volatile("" : "+v"(fr), "+v"(fq));
        const int col0 = u.pn * 256 + wc * 32 + fq * 8, rowa0 = u.pm * 256 + wr * 64, b0 = bid_of(rowa0), b1 = bid_of(rowa0 + 128);
        if (u.sub >= 8) {
            const int sp = u.sub - 8; const bool p0 = (sp & 3) == 0; float* pp = PART + (size_t)sp * 65536 + (size_t)(wr * 64 + fr) * 256 + wc * 32 + fq * 8;
#pragma unroll
            for (int ai = 0; ai < 2; ++ai) { const float* mb = mod + (size_t)(ai ? b1 : b0) * 6144 + 5120 + col0;
#pragma unroll
                for (int bj = 0; bj < 2; ++bj) { const f32x4 g0 = *(const f32x4*)(mb + bj * 128), g1 = *(const f32x4*)(mb + bj * 128 + 4);
                    u32x4 xw[4];
                    if (p0) {
#pragma unroll
                        for (int m = 0; m < 4; ++m) xw[m] = *(const u32x4*)(X1 + (size_t)(rowa0 + ai * 128 + m * 16 + fr) * DM + col0 + bj * 128); }
#pragma unroll
                    for (int m = 0; m < 4; ++m) { f32x4 v0 = g0 * acc[ai][bj][m][0], v1 = g1 * acc[ai][bj][m][1];
                        if (p0) { const u32x4 w = xw[m]; v0 += (f32x4){bf_lo(w.x), bf_hi(w.x), bf_lo(w.y), bf_hi(w.y)}; v1 += (f32x4){bf_lo(w.z), bf_hi(w.z), bf_lo(w.w), bf_hi(w.w)}; }
                        float* q = pp + (size_t)(ai * 128 + m * 16) * 256 + bj * 128; *(f32x4*)q = v0; *(f32x4*)(q + 4) = v1; } } }
            return;
        }
#pragma unroll
        for (int ai = 0; ai < 2; ++ai) { const float* mb = mod + (size_t)(ai ? b1 : b0) * 6144 + 5120 + col0;
            u32x4 xw[4][2]; f32x4 gt[2][2];
#pragma unroll
            for (int m = 0; m < 4; ++m)
#pragma unroll
                for (int bj = 0; bj < 2; ++bj) xw[m][bj] = *(const u32x4*)(X1 + (size_t)(rowa0 + ai * 128 + m * 16 + fr) * DM + col0 + bj * 128);
#pragma unroll
            for (int bj = 0; bj < 2; ++bj) { gt[bj][0] = *(const f32x4*)(mb + bj * 128); gt[bj][1] = *(const f32x4*)(mb + bj * 128 + 4); }
#pragma unroll
            for (int m = 0; m < 4; ++m) { const size_t ro = (size_t)(rowa0 + ai * 128 + m * 16 + fr) * DM;
#pragma unroll
                for (int bj = 0; bj < 2; ++bj) { const int col = col0 + bj * 128; const u32x4 w = xw[m][bj];
                    *(f32x4*)(Y + ro + col) = (f32x4){bf_lo(w.x), bf_hi(w.x), bf_lo(w.y), bf_hi(w.y)} + gt[bj][0] * acc[ai][bj][m][0];
                    *(f32x4*)(Y + ro + col + 4) = (f32x4){bf_lo(w.z), bf_hi(w.z), bf_lo(w.w), bf_hi(w.w)} + gt[bj][1] * acc[ai][bj][m][1]; } } }
    }
};

__device__ __forceinline__ void tr_item(const float* W, int N, int k0, int n0, bf16_t* WT, size_t ldo, int drowA, int drowB, LAS float* scr, int lane) {
    f32x4 v[16];
    const float* wp = W + (size_t)(k0 + (lane >> 4)) * N + n0 + (lane & 15) * 4;
#pragma unroll
    for (int i = 0; i < 16; ++i) v[i] = *(const f32x4*)(wp + (size_t)(4 * i) * N);
#pragma unroll
    for (int i = 0; i < 16; ++i) { LAS float* d = scr + (4 * i + (lane >> 4)) * 65 + (lane & 15) * 4; d[0] = v[i][0]; d[1] = v[i][1]; d[2] = v[i][2]; d[3] = v[i][3]; }
    asm volatile("s_waitcnt lgkmcnt(0)" ::: "memory");
    const int c = lane & 7;
#pragma unroll
    for (int j = 0; j < 8; ++j) { const int n = (lane >> 3) + 8 * j; const LAS float* sp = scr + (8 * c) * 65 + n;
        u32x4 o; o.x = pk2(sp[0 * 65], sp[1 * 65]); o.y = pk2(sp[2 * 65], sp[3 * 65]); o.z = pk2(sp[4 * 65], sp[5 * 65]); o.w = pk2(sp[6 * 65], sp[7 * 65]);
        const int drow = (j < 4 ? drowA + n : drowB + n - 32);
        *(u32x4*)(WT + (size_t)drow * ldo + k0 + 8 * c) = o; }
    asm volatile("s_waitcnt lgkmcnt(0)" ::: "memory");
}
__device__ __forceinline__ int win_dest(int n0) {
    if (n0 < 512) return 256 * (n0 >> 7) + (n0 & 127);
    if (n0 < 1024) { const int n = n0 - 512; return 256 * (n >> 7) + 128 + (n & 127); }
    if (n0 < 2048) { const int base = n0 < 1536 ? 1024 : 1536, n = n0 - base; return base + 256 * (n >> 8) + 128 * ((n & 63) >> 5) + 32 * ((n & 255) >> 6); }
    if (n0 < 2560) return -(n0 - 2048) - 1;
    if (n0 < 3584) { const int n = n0 - 2560; return 2048 + 256 * (n >> 7) + (n & 127); }
    { const int n = n0 - 3584; return 2048 + 256 * (n >> 7) + 128 + (n & 127); }
}
__device__ __forceinline__ int ffn_dest(int n0) { if (n0 < FF) return 256 * (n0 >> 7) + (n0 & 127); const int n = n0 - FF; return 256 * (n >> 7) + 128 + (n & 127); }

template <int MODE> __device__ __forceinline__ void gemv34(LAS unsigned char* lds, int task, const float* W, int N, const float* bias, float* out, const float* cp, const float* cs, const float* mod, int tid, int lane, int wave) {
    LAS float* S = (LAS float*)lds;
    { f32x2 sv[NB];
#pragma unroll
      for (int b = 0; b < NB; ++b) sv[b] = MODE == 0 ? *(const f32x2*)((b < NBP ? cp + b * DM : cs + (b - NBP) * DM) + 2 * tid) : *(const f32x2*)(mod + (size_t)b * 6144 + 3072 + 2 * tid);
#pragma unroll
      for (int b = 0; b < NB; ++b) { f32x2 v = sv[b]; if (MODE == 0) { v[0] *= sigm(v[0]); v[1] *= sigm(v[1]); } *(LAS f32x2*)(S + b * DM + 2 * tid) = v; } }
    __syncthreads();
    float acc[NB];
#pragma unroll
    for (int b = 0; b < NB; ++b) acc[b] = 0.f;
    const int kbase = wave * 128 + (lane >> 5) * 64;
    const float* wp = W + (size_t)kbase * N + task * 32 + (lane & 31);
    const LAS float* sp = S + kbase;
#pragma unroll 2
    for (int k4 = 0; k4 < 16; ++k4) { const float w0 = wp[0], w1 = wp[N], w2 = wp[2 * (size_t)N], w3 = wp[3 * (size_t)N]; wp += 4 * (size_t)N;
#pragma unroll
        for (int b = 0; b < NB; ++b) { const f32x4 s4 = *(const LAS f32x4*)(sp + b * DM + 4 * k4); acc[b] += (s4[0] * w0 + s4[1] * w1) + (s4[2] * w2 + s4[3] * w3); } }
    __syncthreads();
#pragma unroll
    for (int b = 0; b < NB; ++b) S[(wave * NB + b) * 64 + lane] = acc[b];
    __syncthreads();
    for (int idx = tid; idx < NB * 32; idx += NTHREADS) { const int b = idx >> 5, c = idx & 31; float s = 0.f;
#pragma unroll
        for (int w = 0; w < NWAVES; ++w) s += S[(w * NB + b) * 64 + c] + S[(w * NB + b) * 64 + 32 + c];
        out[(size_t)b * N + task * 32 + c] = s + (bias ? bias[task * 32 + c] : 0.f); }
    __syncthreads();
}

__device__ __forceinline__ void conv_unit(int cu, LAS unsigned char* lds, const bf16_t* U, const float* cache_conv, const float* w_dw, const float* b_dw, const float* ln_g, const float* ln_b, bf16_t* Y, float* out, int tid, int lane, int wave) {
    int tokbase, t0, T, seq; const bool samp = cu >= 1024;
    if (!samp) { seq = cu >> 9; t0 = (cu & 511) * 32; tokbase = seq * TP; T = TP; } else { const int c2 = cu - 1024; seq = c2 >> 1; t0 = (c2 & 1) * 32; tokbase = NTP + seq * TS; T = TS; }
    LAS unsigned* inb = (LAS unsigned*)lds;
    LAS float* yb = (LAS float*)(lds + 63488);
    for (int r = wave; r < 62; r += NWAVES) { const int t = t0 - 30 + r;
        if (t >= 0) __builtin_amdgcn_global_load_lds((const unsigned*)(U + (size_t)(tokbase + t) * CD + lane * 8), (LAS unsigned*)(inb + r * 256), 16, 0, 0);
        else { u32x4 v = {0u, 0u, 0u, 0u};
            if (samp) { const float* cc = cache_conv + ((size_t)seq * 30 + 30 + t) * CD + lane * 8; v = pack8(*(const f32x4*)cc, *(const f32x4*)(cc + 4)); }
            *(LAS u32x4*)(inb + r * 256 + lane * 4) = v; } }
    asm volatile("s_waitcnt vmcnt(0)" ::: "memory");
    __syncthreads();
    if (t0 == T - 32) {
        float* o = out + (samp ? OUT_CSS : OUT_CSP) + (size_t)seq * 30 * CD;
        for (int idx = tid; idx < 30 * 256; idx += NTHREADS) { const int r = idx >> 8, c2 = idx & 255; const unsigned v = inb[(32 + r) * 256 + c2]; *(f32x2*)(o + (size_t)r * CD + 2 * c2) = (f32x2){bf_lo(v), bf_hi(v)}; }
    }
    { const int cp = tid & 255, half = tid >> 8;
      f32x2 w[CK];
#pragma unroll
      for (int j = 0; j < CK; ++j) w[j] = *(const f32x2*)(w_dw + j * CD + 2 * cp);
      const f32x2 bb = *(const f32x2*)(b_dw + 2 * cp);
      f32x2 acc[16];
#pragma unroll
      for (int o = 0; o < 16; ++o) acc[o] = bb;
      const LAS unsigned* ip = inb + (16 * half) * 256 + cp; unsigned vc = ip[0], vn = 0u;
#pragma unroll
      for (int i = 0; i < 46; ++i) { if (i + 1 < 46) vn = ip[(i + 1) * 256]; const f32x2 x = {bf_lo(vc), bf_hi(vc)};
#pragma unroll
          for (int o = 0; o < 16; ++o) { const int j = i - o; if (j >= 0 && j < CK) acc[o] += w[j] * x; }
          __builtin_amdgcn_sched_barrier(0); vc = vn; }
#pragma unroll
      for (int o = 0; o < 16; ++o) *(LAS f32x2*)(yb + (16 * half + o) * CD + 2 * cp) = acc[o];
    }
    __syncthreads();
    const f32x4 g0 = *(const f32x4*)(ln_g + lane * 8), g1 = *(const f32x4*)(ln_g + lane * 8 + 4), b0 = *(const f32x4*)(ln_b + lane * 8), b1 = *(const f32x4*)(ln_b + lane * 8 + 4);
#pragma unroll
    for (int rr = 0; rr < 4; ++rr) { const int row = wave * 4 + rr;
        f32x4 v0 = *(const LAS f32x4*)(yb + row * CD + lane * 8), v1 = *(const LAS f32x4*)(yb + row * CD + lane * 8 + 4);
        const float mu = wave_sum((v0[0] + v0[1]) + (v0[2] + v0[3]) + (v1[0] + v1[1]) + (v1[2] + v1[3])) * (1.f / CD);
        v0 = v0 - mu; v1 = v1 - mu;
        const float var = wave_sum((v0[0] * v0[0] + v0[1] * v0[1]) + (v0[2] * v0[2] + v0[3] * v0[3]) + (v1[0] * v1[0] + v1[1] * v1[1]) + (v1[2] * v1[2] + v1[3] * v1[3])) * (1.f / CD);
        const float rstd = rsqrtf(var + EPS);
        v0 = v0 * rstd * g0 + b0; v1 = v1 * rstd * g1 + b1;
#pragma unroll
        for (int e = 0; e < 4; ++e) { v0[e] *= sigm(v0[e]); v1[e] *= sigm(v1[e]); }
        *(u32x4*)(Y + (size_t)(tokbase + t0 + row) * CD + lane * 8) = pack8(v0, v1); }
    __syncthreads();
}

__device__ __forceinline__ int crow(int r, int hi) { return (r & 3) + 8 * (r >> 2) + 4 * hi; }
__device__ __forceinline__ float max3f(float a, float b, float c) { float r; asm("v_max3_f32 %0, %1, %2, %3" : "=v"(r) : "v"(a), "v"(b), "v"(c)); return r; }
__device__ __forceinline__ float max2f(float a, float b) { float r; asm("v_max_f32_e32 %0, %1, %2" : "=v"(r) : "v"(a), "v"(b)); return r; }
#define MFMA32(a, b, c) __builtin_amdgcn_mfma_f32_32x32x16_bf16((a), (b), (c), 0, 0, 0)
__device__ __forceinline__ void attn_unit(int wu, const bf16_t* Q, const bf16_t* K, const bf16_t* VT, bf16_t* O, const LAS float* rb, int lane) {
    const int r32 = lane & 31, hi = lane >> 5;
    int h, qtok0, jstart, cb, half;
    if (wu < 8192) { half = wu & 1; const int n = (wu >> 1) & 255; h = (wu >> 9) & 7; const int b = wu >> 12; qtok0 = b * TP + 64 * n + 32 * half; cb = b * 256 + n - 8; jstart = n < 8 ? 8 - n : 0; }
    else { const int w2 = wu - 8192; half = w2 & 1; h = (w2 >> 1) & 7; const int sb = w2 >> 4; qtok0 = NTP + sb * TS + 32 * half; cb = 512 + sb * 9; jstart = 0; }
    const bf16_t* Kt = K + ((size_t)(cb * NHEAD + h)) * 4096 + lane * 8; const bf16_t* Vt = VT + ((size_t)(cb * NHEAD + h)) * 4096 + lane * 8;
    bf16x8 qf[4];
    { const bf16_t* qp = Q + (size_t)(qtok0 + r32) * AD + h * HD + 8 * hi;
#pragma unroll
      for (int d0 = 0; d0 < 4; ++d0) qf[d0] = *(const bf16x8*)(qp + 16 * d0); }
    const int qi = 32 * half + r32; const LAS float* rbh = rb + h * 257;
    float mref = 0.f, l = 0.f; f32x16 o0 = {}, o1 = {}, negm = {};
    bf16x8 kf[2][8];
#pragma unroll
    for (int j = 0; j < 9; ++j) {
        if (j == jstart) {
#pragma unroll
            for (int i = 0; i < 8; ++i) kf[j & 1][i] = *(const bf16x8*)(Kt + (size_t)j * 32768 + i * 512);
        }
        if (j >= jstart) {
            const bool first = (j == jstart);
            bf16x8 vf[8];
#pragma unroll
            for (int i = 0; i < 8; ++i) vf[i] = *(const bf16x8*)(Vt + (size_t)j * 32768 + i * 512);
            if (j < 8) {
#pragma unroll
                for (int i = 0; i < 8; ++i) kf[(j + 1) & 1][i] = *(const bf16x8*)(Kt + (size_t)(j + 1) * 32768 + i * 512);
            }
            f32x16 p0, p1;
            p0 = MFMA32(kf[j & 1][0], qf[0], negm); p1 = MFMA32(kf[j & 1][4], qf[0], negm);
#pragma unroll
            for (int d0 = 1; d0 < 4; ++d0) { p0 = MFMA32(kf[j & 1][d0], qf[d0], p0); p1 = MFMA32(kf[j & 1][4 + d0], qf[d0], p1); }
            asm volatile("s_nop 15\n\ts_nop 7" : "+v"(p0), "+v"(p1));
            const int c = 8 - j;
            if (c < 3) { const int base = 64 * c + qi + 128;
#pragma unroll
                for (int i = 0; i < 16; ++i) { const int kv = crow(i, hi); const int i0 = base - kv, i1 = base - kv - 32; p0[i] += rbh[i0 > 256 ? 256 : i0]; p1[i] += rbh[i1 > 256 ? 256 : i1]; }
            }
            float ma = max3f(p0[0], p0[1], p1[0]), mb = max3f(p0[2], p0[3], p1[1]); ma = max3f(ma, p1[2], p1[3]);
#pragma unroll
            for (int i = 4; i < 16; i += 4) { ma = max3f(ma, p0[i], p0[i + 1]); mb = max3f(mb, p0[i + 2], p0[i + 3]); ma = max3f(ma, p1[i], p1[i + 1]); mb = max3f(mb, p1[i + 2], p1[i + 3]); }
            float mt = max2f(ma, mb); mt = max2f(mt, __shfl_xor(mt, 32));
            if (first || __any(mt > 8.f)) { const float dl = first ? mt : fmaxf(mt, 0.f), f = first ? 1.f : __builtin_amdgcn_exp2f(-dl); mref += dl; l *= f;
#pragma unroll
                for (int i = 0; i < 16; ++i) { o0[i] *= f; o1[i] *= f; p0[i] -= dl; p1[i] -= dl; negm[i] = -mref; } }
            float ls = 0.f;
#pragma unroll
            for (int i = 0; i < 16; ++i) { p0[i] = __builtin_amdgcn_exp2f(p0[i]); p1[i] = __builtin_amdgcn_exp2f(p1[i]); ls += p0[i] + p1[i]; }
            l += ls;
            u32x4 pw[4];
#pragma unroll
            for (int s2 = 0; s2 < 2; ++s2) { pw[s2] = (u32x4){pk2(p0[8 * s2], p0[8 * s2 + 1]), pk2(p0[8 * s2 + 2], p0[8 * s2 + 3]), pk2(p0[8 * s2 + 4], p0[8 * s2 + 5]), pk2(p0[8 * s2 + 6], p0[8 * s2 + 7])};
                                             pw[2 + s2] = (u32x4){pk2(p1[8 * s2], p1[8 * s2 + 1]), pk2(p1[8 * s2 + 2], p1[8 * s2 + 3]), pk2(p1[8 * s2 + 4], p1[8 * s2 + 5]), pk2(p1[8 * s2 + 6], p1[8 * s2 + 7])}; }
#pragma unroll
            for (int s2 = 0; s2 < 4; ++s2) { const bf16x8 pa = __builtin_bit_cast(bf16x8, pw[s2]); o0 = MFMA32(vf[s2], pa, o0); o1 = MFMA32(vf[4 + s2], pa, o1); }
        }
    }
    l += __shfl_xor(l, 32); const float inv = 1.f / l;
    bf16_t* op = O + (size_t)(qtok0 + r32) * AD + h * HD + 4 * hi;
#pragma unroll
    for (int g = 0; g < 4; ++g) {
        *(u32x2*)(op + 8 * g) = (u32x2){pk2(o0[4 * g] * inv, o0[4 * g + 1] * inv), pk2(o0[4 * g + 2] * inv, o0[4 * g + 3] * inv)};
        *(u32x2*)(op + 32 + 8 * g) = (u32x2){pk2(o1[4 * g] * inv, o1[4 * g + 1] * inv), pk2(o1[4 * g + 2] * inv, o1[4 * g + 3] * inv)}; }
}

#define XB_TMO      128
#define XB_XCNT(j)  (256  + 64 * (j))
#define XB_XSUB(j)  (1280 + 64 * (j))
#define XB_XGEN(j)  (2304 + 64 * (j))
#define XB_TOP      3328
#define XB_TOPGEN   3392
#define XCD_BAR_WORDS 3456
#define XB_SPIN_CAP (1u << 18)

__device__ __forceinline__ unsigned xb_ld(unsigned* p)              { return __hip_atomic_load(p, __ATOMIC_RELAXED, __HIP_MEMORY_SCOPE_AGENT); }
__device__ __forceinline__ unsigned xb_add(unsigned* p, unsigned v) { return __hip_atomic_fetch_add(p, v, __ATOMIC_RELAXED, __HIP_MEMORY_SCOPE_AGENT); }
__device__ __forceinline__ unsigned xb_xcc_id() { return (unsigned)__builtin_amdgcn_s_getreg((3 << 11) | 20) & 0xFu; }
#define XB_SPIN(cond, bar) do { unsigned _sp = 0; while (cond) { __builtin_amdgcn_s_sleep(1); \
    if ((++_sp & 255u) == 0u) { if (xb_ld(&(bar)[XB_TMO])) break; if (_sp > XB_SPIN_CAP) { atomicAdd(&(bar)[XB_TMO], 1u); break; } } } } while (0)

struct XcdBarrier {
    unsigned* bar; unsigned x;
    volatile LAS unsigned* st;
};

__device__ __forceinline__ XcdBarrier xcd_barrier_post(unsigned* bar, volatile LAS unsigned* st) {
    XcdBarrier b; b.bar = bar; b.x = xb_xcc_id(); b.st = st;
    if (threadIdx.x == 0) (void)xb_add(&bar[XB_XCNT(b.x)], 1u);
    return b;
}
__device__ __forceinline__ void xcd_barrier_complete(unsigned* bar, unsigned x, unsigned& nloc, unsigned& nx) {
    const unsigned G = gridDim.x * gridDim.y * gridDim.z;
    unsigned sum, cnt, mine, sp = 0u;
    for (;;) {
        sum = 0u; cnt = 0u; mine = 0u;
#pragma unroll
        for (unsigned j = 0; j < 16; ++j) { const unsigned c = xb_ld(&bar[XB_XCNT(j)]); sum += c; cnt += (c > 0u) ? 1u : 0u; mine = (j == x) ? c : mine; }
        if (sum == G) break;
        __builtin_amdgcn_s_sleep(1);
        if ((++sp & 255u) == 0u) { if (xb_ld(&bar[XB_TMO])) break; if (sp > XB_SPIN_CAP) { atomicAdd(&bar[XB_TMO], 1u); break; } }
    }
    nloc = mine > 0u ? mine : 1u; nx = cnt > 0u ? cnt : 1u;
}

__device__ __forceinline__ void xcd_barrier(const XcdBarrier& b) {
    asm volatile("s_waitcnt vmcnt(0)" ::: "memory");
    __syncthreads();
    if (threadIdx.x == 0) {
        unsigned* bar = b.bar;
        __builtin_amdgcn_s_waitcnt(0);
        unsigned nloc = b.st[0], nx = b.st[1];
        if (nloc == 0u) { xcd_barrier_complete(bar, b.x, nloc, nx); b.st[0] = nloc; b.st[1] = nx; }
        const unsigned old = xb_add(&bar[XB_XSUB(b.x)], 1u);
        const unsigned gen = old / nloc;
        if (old + 1u == (gen + 1u) * nloc) {
            __builtin_amdgcn_fence(__ATOMIC_RELEASE, "agent");
            asm volatile("s_waitcnt vmcnt(0)" ::: "memory");
            const unsigned og = xb_add(&bar[XB_TOP], 1u);
            const unsigned tg = og / nx;
            if (og + 1u == (tg + 1u) * nx) xb_add(&bar[XB_TOPGEN], 1u);
            else XB_SPIN(xb_ld(&bar[XB_TOPGEN]) == tg, bar);
            __builtin_amdgcn_fence(__ATOMIC_ACQUIRE, "agent");
            xb_add(&bar[XB_XGEN(b.x)], 1u);
            asm volatile("s_waitcnt vmcnt(0)" ::: "memory");
        } else {
            XB_SPIN(xb_ld(&bar[XB_XGEN(b.x)]) == gen, bar);
            __builtin_amdgcn_fence(__ATOMIC_ACQUIRE, "agent");
            asm volatile("s_waitcnt vmcnt(0)" ::: "memory");
        }
    }
    __syncthreads();
}

struct Args { const float* in[24]; float* out; unsigned char* ws; int ph_lo, ph_hi; };
enum { I_XP = 0, I_XS, I_CP, I_CS, I_CCONV, I_CK, I_CV, I_N1G, I_N2G, I_WADA, I_BADA, I_WIN, I_WDW, I_BDW, I_LNG, I_LNB, I_WCO, I_QG, I_KG, I_RB, I_WAO, I_WO, I_WF1, I_WF2 };
constexpr int NPHASE = 8;

__global__ void __launch_bounds__(NTHREADS, 2) fwd_mega(Args a) {
    extern __shared__ __attribute__((aligned(16))) unsigned char lds_raw[];
    LAS unsigned char* lds = (LAS unsigned char*)lds_raw;
    cg::grid_group grid = cg::this_grid();
    const int tid = threadIdx.x, lane = tid & 63, wave = __builtin_amdgcn_readfirstlane(tid >> 6);
    const int G = gridDim.x, bx = blockIdx.x;
    const int vcu = (G % 8 == 0) ? (bx % 8) * (G / 8) + bx / 8 : bx;
    const int gw = vcu * NWAVES + wave, NGW = G * NWAVES;
    unsigned char* ws = a.ws; float* out = a.out;
    float* MOD = (float*)(ws + WS_MOD); float* CVEC = (float*)(ws + WS_CVEC); float* SS = (float*)(ws + WS_SS);
    bf16_t *WC = (bf16_t*)(ws + WS_WC), *WA = (bf16_t*)(ws + WS_WA), *WO = (bf16_t*)(ws + WS_WO), *WF1 = (bf16_t*)(ws + WS_WF1), *WF2 = (bf16_t*)(ws + WS_WF2), *WIN = (bf16_t*)(ws + WS_WIN), *WV = (bf16_t*)(ws + WS_WV);
    bf16_t *H = (bf16_t*)(ws + WS_H), *U = (bf16_t*)(ws + WS_U), *Q = (bf16_t*)(ws + WS_Q), *KB = (bf16_t*)(ws + WS_K), *VT = (bf16_t*)(ws + WS_VT), *SG = (bf16_t*)(ws + WS_SG);
    bf16_t *Y = (bf16_t*)(ws + WS_Y), *O = (bf16_t*)(ws + WS_O), *M1 = (bf16_t*)(ws + WS_M1), *MG = (bf16_t*)(ws + WS_MG), *A2 = (bf16_t*)(ws + WS_A2), *ACT = (bf16_t*)(ws + WS_ACT);
    const int lo = a.ph_lo, hi = a.ph_hi;
    unsigned* barw = (unsigned*)(ws + WS_BAR);
    volatile LAS unsigned* bst = (volatile LAS unsigned*)(lds + LDS_BYTES - 64);
    if (tid < 2) bst[tid] = 0u;
    __syncthreads();
    XcdBarrier xbar = xcd_barrier_post(barw, bst);
    if (lo < 0) grid.sync();
#define IN(k) (lo <= (k) && (k) < hi)
#define SEAM(k) do { if (IN(k) && IN((k) + 1)) xcd_barrier(xbar); } while (0)
#ifndef PROBE_MASK
#define PROBE_MASK 0
#endif
#define REPS(k) ((((PROBE_MASK) >> (k)) & 1) + 1)
#define REPSYNC(k) do { if (rep + 1 < REPS(k)) xcd_barrier(xbar); } while (0)

    if (IN(0)) for (int rep = 0; rep < REPS(0); ++rep) {
        for (int task = bx; task < 6144 / 32; task += G) gemv34<0>(lds, task, a.in[I_WADA], 6144, a.in[I_BADA], MOD, a.in[I_CP], a.in[I_CS], nullptr, tid, lane, wave);
        LAS float* scr = (LAS float*)(lds + wave * 16640);
        constexpr int I1 = 16 * 72, I2 = 8 * 16, I3 = 8 * 16, I4 = 16 * 16, I5 = 16 * 88, I6 = 44 * 16, I7 = 32 * 8 * 8, NIT = I1 + I2 + I3 + I4 + I5 + I6 + I7;
        for (int it = gw; it < NIT; it += NGW) { int r = it;
            if (r < I1) { const int kb = r / 72, nb = r % 72, dA = win_dest(nb * 64), dB = win_dest(nb * 64 + 32);
                if (dA >= 0) tr_item(a.in[I_WIN], NIN, kb * 64, nb * 64, WIN, DM, dA, dB, scr, lane); else tr_item(a.in[I_WIN], NIN, kb * 64, nb * 64, WV, DM, -dA - 1, -dB - 1, scr, lane); continue; } r -= I1;
            if (r < I2) { tr_item(a.in[I_WCO], DM, (r / 16) * 64, (r % 16) * 64, WC, CD, (r % 16) * 64, (r % 16) * 64 + 32, scr, lane); continue; } r -= I2;
            if (r < I3) { tr_item(a.in[I_WAO], DM, (r / 16) * 64, (r % 16) * 64, WA, AD, (r % 16) * 64, (r % 16) * 64 + 32, scr, lane); continue; } r -= I3;
            if (r < I4) { tr_item(a.in[I_WO], DM, (r / 16) * 64, (r % 16) * 64, WO, DM, (r % 16) * 64, (r % 16) * 64 + 32, scr, lane); continue; } r -= I4;
            if (r < I5) { const int kb = r / 88, nb = r % 88; tr_item(a.in[I_WF1], 2 * FF, kb * 64, nb * 64, WF1, DM, ffn_dest(nb * 64), ffn_dest(nb * 64 + 32), scr, lane); continue; } r -= I5;
            if (r < I6) { tr_item(a.in[I_WF2], DM, (r / 16) * 64, (r % 16) * 64, WF2, FF, (r % 16) * 64, (r % 16) * 64 + 32, scr, lane); continue; } r -= I6;
            { const int sb = r >> 6, cc = (r >> 3) & 7, hh = r & 7;
              const float* src = a.in[I_CV] + ((size_t)sb * BANDP + cc * 64) * AD + hh * HD + (lane & 31); bf16_t* dst = VT + ((size_t)((512 + sb * 9 + cc) * NHEAD + hh)) * 4096 + lane * 8; const int hi4 = (lane >> 5) * 4;
#pragma unroll
              for (int db = 0; db < 2; ++db)
#pragma unroll
                  for (int s4 = 0; s4 < 4; ++s4) { float v[8];
#pragma unroll
                      for (int j = 0; j < 8; ++j) v[j] = src[(size_t)(16 * s4 + 8 * (j >> 2) + hi4 + (j & 3)) * AD + 32 * db];
                      *(u32x4*)(dst + (db * 4 + s4) * 512) = (u32x4){pk2(v[0], v[1]), pk2(v[2], v[3]), pk2(v[4], v[5]), pk2(v[6], v[7])}; } }
        }
#pragma unroll 4
        for (int r = gw; r < NBS * BANDP; r += NGW) { const int sb = r >> 9, i = r & 511; const float* sp = a.in[I_CK] + (size_t)r * AD + lane * 8; const int kidx = NTP + sb * SKV + i;
            *(u32x4*)(KB + ((size_t)((kidx >> 6) * NHEAD + (lane >> 3)) * 8 + ((kidx >> 5) & 1) * 4 + ((lane & 7) >> 1)) * 512 + ((lane & 1) * 32 + (kidx & 31)) * 8) = pack8(*(const f32x4*)sp, *(const f32x4*)(sp + 4)); }
        REPSYNC(0);
    }
    SEAM(0);
    if ((PROBE_MASK >> 9) & 1) { for (int e = 0; e < 8; ++e) xcd_barrier(xbar); }
    if (IN(1)) for (int rep = 0; rep < REPS(1); ++rep) {
        for (int task = bx; task < (2 * FF) / 32; task += G) gemv34<1>(lds, task, a.in[I_WF1], 2 * FF, nullptr, CVEC, nullptr, nullptr, MOD, tid, lane, wave);
        const float* g1 = a.in[I_N1G];
        const bool bal = (G == 256); constexpr int NGV = 176 * NWAVES, NG1 = 4 * NGV;
        const int gstart = !bal ? gw : (bx < 176 ? bx * NWAVES + wave : NG1 + (bx - 176) * NWAVES + wave), gstep = !bal ? NGW : (bx < 176 ? NGV : (256 - 176) * NWAVES), gend = (bal && bx < 176) ? NG1 : NTOK / 4;
#define P1_LOAD(G4, V, GM, SH) do { const int row0_ = 4 * (G4); const float* xr_ = row0_ < NTP ? a.in[I_XP] + (size_t)row0_ * DM : a.in[I_XS] + (size_t)(row0_ - NTP) * DM; const float* mb_ = MOD + (size_t)bid_of(row0_) * 6144; \
            _Pragma("unroll") for (int r = 0; r < 4; ++r) _Pragma("unroll") for (int j = 0; j < 4; ++j) V[r][j] = *(const f32x4*)(xr_ + (size_t)r * DM + 4 * lane + 256 * j); \
            _Pragma("unroll") for (int j = 0; j < 4; ++j) { const int col_ = 4 * lane + 256 * j; GM[j] = *(const f32x4*)(g1 + col_) * (*(const f32x4*)(mb_ + 1024 + col_) + 1.f); SH[j] = *(const f32x4*)(mb_ + col_); } } while (0)
        { f32x4 v[4][4], gm[4], sh[4], vn[4][4], gmn[4], shn[4];
          int g4 = gstart; if (g4 < gend) P1_LOAD(g4, v, gm, sh);
          while (g4 < gend) { const int gn = g4 + gstep; if (gn < gend) P1_LOAD(gn, vn, gmn, shn);
#pragma unroll
            for (int r = 0; r < 4; ++r) { float ss = 0.f;
#pragma unroll
                for (int j = 0; j < 4; ++j) ss += (v[r][j][0] * v[r][j][0] + v[r][j][1] * v[r][j][1]) + (v[r][j][2] * v[r][j][2] + v[r][j][3] * v[r][j][3]);
                const float rstd = rsqrtf(wave_sum(ss) * (1.f / DM) + EPS);
#pragma unroll
                for (int j = 0; j < 4; ++j) { const f32x4 hh = v[r][j] * rstd * gm[j] + sh[j];
                    *(u32x2*)(H + (size_t)(4 * g4 + r) * DM + 4 * lane + 256 * j) = (u32x2){pk2(hh[0], hh[1]), pk2(hh[2], hh[3])}; } }
#pragma unroll
            for (int r = 0; r < 4; ++r)
#pragma unroll
                for (int j = 0; j < 4; ++j) v[r][j] = vn[r][j];
#pragma unroll
            for (int j = 0; j < 4; ++j) { gm[j] = gmn[j]; sh[j] = shn[j]; }
            g4 = gn; } }
#undef P1_LOAD
        REPSYNC(1);
    }
    SEAM(1);
    if (IN(2)) for (int rep = 0; rep < REPS(2); ++rep) {
        pg8::Gemm g{WIN, WIN, NTOK, 4096, DM}; OrderIn S; S.init(G, bx);
        EpiIn E{U, Q, KB, VT, SG, out, a.in[I_QG], a.in[I_KG]};
        pg8::gemm_phase<EpiIn, OrderIn, true, true>(lds, g, S, E);
        REPSYNC(2);
    }
    SEAM(2);
    if (IN(3)) {
        const bool cbal = (G == 256); const int cfirst = !cbal ? bx : (vcu < 64 ? 960 + vcu : vcu - 64), cstep = !cbal ? G : (vcu < 64 ? 64 : 192), cend = (cbal && vcu >= 64) ? 960 : 1024 + 64;
        for (int rep = 0; rep < REPS(3); ++rep)
        for (int cu = cfirst; cu < cend; cu += cstep) conv_unit(cu, lds, U, a.in[I_CCONV], a.in[I_WDW], a.in[I_BDW], a.in[I_LNG], a.in[I_LNB], Y, out, tid, lane, wave);
        LAS float* rb = (LAS float*)lds;
        for (int idx = tid; idx < NHEAD * 257; idx += NTHREADS) rb[idx] = (a.in[I_RB][idx] - a.in[I_RB][(idx / 257) * 257 + 256]) * LOG2E;
        __syncthreads();
        for (int rep = 0; rep < REPS(8); ++rep)
        for (int wu = gw; wu < 8192 + 512; wu += NGW) attn_unit(wu, Q, KB, VT, O, rb, lane);
        __syncthreads();
    }
    SEAM(3);
    if (IN(4)) for (int rep = 0; rep < REPS(4); ++rep) {
        static_assert(WS_O - WS_Y == (size_t)NROWT * 256 * CD * 2 && WS_WA - WS_WC == (size_t)4 * 256 * CD * 2, "concatenated [Y | O] and [Wc | Wa] tile spaces");
        PairOrder S; S.init(NTOK, DM, G, bx); pg8::Gemm g{Y, WC, NTOK, DM, CD}; EpiMergeFused E{SG, MG};
        pg8::gemm_phase<EpiMergeFused, PairOrder, true, true>(lds, g, S, E);
        REPSYNC(4);
    }
    SEAM(4);
    if (IN(5)) for (int rep = 0; rep < REPS(5); ++rep) {
        pg8::TailOrder S; S.init(NTOK, DM, G, bx); pg8::Gemm g{MG, WO, NTOK, DM, DM};
        EpiX1 E{a.in[I_XP], a.in[I_XS], MOD, a.in[I_N2G], (bf16_t*)(ws + WS_X1), A2, SS};
        pg8::gemm_phase<EpiX1, pg8::TailOrder, true, true>(lds, g, S, E);
        REPSYNC(5);
    }
    SEAM(5);
    if (IN(6)) for (int rep = 0; rep < REPS(6); ++rep) {
        pg8::StaticOrder S; S.init(NTOK, 2 * FF, G, bx); pg8::Gemm g{A2, WF1, NTOK, 2 * FF, DM};
        EpiFfn E{SS, CVEC, ACT};
        pg8::gemm_phase<EpiFfn, pg8::StaticOrder, true, true>(lds, g, S, E);
        REPSYNC(6);
    }
    SEAM(6);
    if (IN(7)) {
        pg8::KSplitOrder S; S.init(NTOK, DM, G, bx); pg8::Gemm g{ACT, WF2, NTOK, DM, FF};
        EpiOut E{MOD, (const bf16_t*)(ws + WS_X1), out + OUT_Y, (float*)(ws + WS_PART)};
        pg8::gemm_phase<EpiOut, pg8::KSplitOrder, true, true>(lds, g, S, E);
        { const int nleft = S.so.nwg - S.nfull;
          if (nleft > 0) { xcd_barrier(xbar); const float* PT = (const float*)(ws + WS_PART);
            for (int it = bx * NTHREADS + tid; it < nleft * 16384; it += G * NTHREADS) { const int slot = it >> 14, e4 = it & 16383, r = e4 >> 6, c4 = (e4 & 63) * 4; pg8::Unit zu; S.so.map(S.nfull + slot, zu);
                const float* q = PT + (size_t)slot * 4 * 65536 + (size_t)r * 256 + c4;
                const f32x4 v = (*(const f32x4*)q + *(const f32x4*)(q + 65536)) + (*(const f32x4*)(q + 2 * 65536) + *(const f32x4*)(q + 3 * 65536));
                *(f32x4*)(out + OUT_Y + (size_t)(zu.pm * 256 + r) * DM + zu.pn * 256 + c4) = v; } } }
    }
#undef IN
#undef SEAM
}

#ifndef MK_SPLIT
#define MK_SPLIT 0
#endif
extern "C" void kernel_launch(void* const* d_in, const int* in_sizes, int n_in, void* d_out, int out_size, void* d_ws, size_t ws_size, hipStream_t stream) {
    static int grid = 0;
    if (grid == 0) {
        if (n_in != 24 || out_size != (int)OUT_END || ws_size < WS_END) { fprintf(stderr, "kernel_launch: unexpected problem (n_in %d, out %d, ws %zu)\n", n_in, out_size, ws_size); grid = -1; return; }
        int dev = 0, cus = 0, per_cu = 0;
        hipGetDevice(&dev); hipDeviceGetAttribute(&cus, hipDeviceAttributeMultiprocessorCount, dev);
        hipFuncSetAttribute((const void*)fwd_mega, hipFuncAttributeMaxDynamicSharedMemorySize, LDS_BYTES);
        hipOccupancyMaxActiveBlocksPerMultiprocessor(&per_cu, (const void*)fwd_mega, NTHREADS, LDS_BYTES);
        if (per_cu < 1) { fprintf(stderr, "kernel_launch: occupancy query says %d blocks per CU\n", per_cu); grid = -1; return; }
        grid = cus * 1;
    }
    if (grid < 0) return;
    Args a{};
    for (int i = 0; i < 24; ++i) a.in[i] = (const float*)d_in[i];
    a.out = (float*)d_out; a.ws = (unsigned char*)d_ws;
#if MK_SPLIT
    for (int p = 0; p < NPHASE; ++p) { a.ph_lo = p; a.ph_hi = p + 1; void* args[] = {&a};
        hipError_t e = hipLaunchCooperativeKernel((const void*)fwd_mega, dim3(grid), dim3(NTHREADS), args, LDS_BYTES, stream);
        if (e != hipSuccess) { fprintf(stderr, "launch %d failed: %s\n", p, hipGetErrorString(e)); break; } }
#else
    if (hipMemsetAsync((char*)d_ws + WS_BAR, 0, 16384, stream) != hipSuccess) { fprintf(stderr, "kernel_launch: memset of the barrier words failed\n"); return; }
    a.ph_lo = 0; a.ph_hi = NPHASE; void* args[] = {&a};
    hipError_t e = hipLaunchCooperativeKernel((const void*)fwd_mega, dim3(grid), dim3(NTHREADS), args, LDS_BYTES, stream);
    if (e != hipSuccess) fprintf(stderr, "cooperative launch failed: %s (grid %d)\n", hipGetErrorString(e), grid);
#endif
}
```
